# Optimizing an MI355X kernel written in HIP

```python
import math
import jax
import jax.numpy as jnp
from jax import lax
import numpy as np

D_MODEL = 1024
BATCH = 8
SEQ = 8192
DEPTH = 4

N_HEADS = 8
N_KV_HEADS = 2
HEAD_DIM = D_MODEL // N_HEADS
GROUP = N_HEADS // N_KV_HEADS
Q_DIM = N_HEADS * HEAD_DIM
KV_DIM = N_KV_HEADS * HEAD_DIM
WINDOW = 128
BLOCK = 128
NUM_BUCKETS = 32
MAX_DISTANCE = 128
LRU_WIDTH = D_MODEL
LRU_BLOCKS = 8
LRU_BLOCK_DIM = LRU_WIDTH // LRU_BLOCKS
LRU_C = 8.0
CONV_WIDTH = 4
CONV_LEFT = 2
N_DIRS = 2
D_FF = 4 * D_MODEL
EPS = 1e-6
SPLITS = (Q_DIM, KV_DIM, KV_DIM, LRU_WIDTH, LRU_WIDTH, D_MODEL, D_MODEL)
IN_COLS = sum(SPLITS)

kernel_name = "hybrid_swa_rglru_encoder"


def rms_norm(x, g):
    xf = x.astype(jnp.float32)
    y = xf * lax.rsqrt(jnp.mean(xf * xf, axis=-1, keepdims=True) + EPS)
    return (y * g.astype(jnp.float32)).astype(x.dtype)


def t5_bucket(rel):
    half = NUM_BUCKETS // 2
    max_exact = half // 2
    n = jnp.abs(rel)
    large = max_exact + (jnp.log(jnp.maximum(n, 1).astype(jnp.float32) / max_exact)
                         / math.log(MAX_DISTANCE / max_exact) * (half - max_exact)).astype(jnp.int32)
    large = jnp.minimum(large, half - 1)
    return jnp.where(rel > 0, half, 0) + jnp.where(n < max_exact, n, large)


def band_blocks(t):
    b, s = t.shape[0], t.shape[1]
    nb = s // BLOCK
    tp = jnp.pad(t, ((0, 0), (BLOCK, BLOCK), (0, 0), (0, 0)))
    tb = tp.reshape(b, nb + 2, BLOCK, t.shape[2], t.shape[3])
    return jnp.concatenate([tb[:, :-2], tb[:, 1:-1], tb[:, 2:]], axis=2)


def windowed_gqa(q, k, v, sink, rel_bias):
    b, s = q.shape[0], q.shape[1]
    nb = s // BLOCK
    qb = q.reshape(b, nb, BLOCK, N_KV_HEADS, GROUP, HEAD_DIM)
    kb = band_blocks(k.reshape(b, s, N_KV_HEADS, HEAD_DIM))
    vb = band_blocks(v.reshape(b, s, N_KV_HEADS, HEAD_DIM))
    scores = jnp.einsum('bnqkgd,bnjkd->bnkgqj', qb, kb).astype(jnp.float32) * (HEAD_DIM ** -0.5)
    q_off = jnp.arange(BLOCK, dtype=jnp.int32)[:, None]
    j_off = jnp.arange(3 * BLOCK, dtype=jnp.int32)[None, :] - BLOCK
    rel = j_off - q_off
    bias = rel_bias.astype(jnp.float32)[t5_bucket(rel)]
    bias = jnp.transpose(bias, (2, 0, 1)).reshape(N_KV_HEADS, GROUP, BLOCK, 3 * BLOCK)
    k_abs = jnp.arange(nb, dtype=jnp.int32)[:, None] * BLOCK + j_off
    valid = (jnp.abs(rel) <= WINDOW)[None] & ((k_abs >= 0) & (k_abs < s))[:, None, :]
    logits = jnp.where(valid[None, :, None, None], scores + bias, -jnp.inf)
    sink_l = sink.astype(jnp.float32).reshape(1, 1, N_KV_HEADS, GROUP, 1, 1)
    m = jnp.maximum(jnp.max(logits, axis=-1, keepdims=True), sink_l)
    p = jnp.exp(logits - m)
    denom = jnp.sum(p, axis=-1, keepdims=True) + jnp.exp(sink_l - m)
    p = (p / denom).astype(v.dtype)
    out = jnp.einsum('bnkgqj,bnjkd->bnqkgd', p, vb)
    return out.reshape(b, s, Q_DIM)


def _lin_combine(e1, e2):
    a1, b1 = e1
    a2, b2 = e2
    return a1 * a2, a2 * b1 + b2


def rg_lru_bidir(xr, gate, conv_w, conv_b, w_rg, b_rg, w_ig, b_ig, lam):
    b, s = xr.shape[0], xr.shape[1]
    xf = xr.astype(jnp.float32)
    xp = jnp.pad(xf, ((0, 0), (CONV_LEFT, CONV_WIDTH - 1 - CONV_LEFT), (0, 0)))
    cw = conv_w.astype(jnp.float32)
    xc = conv_b.astype(jnp.float32) + xp[:, 0:s] * cw[0]
    for j in range(1, CONV_WIDTH):
        xc = xc + xp[:, j:j + s] * cw[j]
    xblk = xc.reshape(b, s, LRU_BLOCKS, LRU_BLOCK_DIM)
    outs = []
    for d in range(N_DIRS):
        r = jax.nn.sigmoid(jnp.einsum('bsnh,nhk->bsnk', xblk, w_rg[d].astype(jnp.float32)).reshape(b, s, LRU_WIDTH)
                           + b_rg[d].astype(jnp.float32))
        i = jax.nn.sigmoid(jnp.einsum('bsnh,nhk->bsnk', xblk, w_ig[d].astype(jnp.float32)).reshape(b, s, LRU_WIDTH)
                           + b_ig[d].astype(jnp.float32))
        log_a = -LRU_C * r * jax.nn.softplus(-lam[d].astype(jnp.float32))
        a = jnp.exp(log_a)
        mult = jnp.sqrt(-jnp.expm1(2.0 * log_a))
        _, hs = lax.associative_scan(_lin_combine, (a, mult * (i * xc)), axis=1, reverse=(d == 1))
        outs.append(hs)
    y = outs[0] + outs[1]
    return (y * jax.nn.gelu(gate.astype(jnp.float32))).astype(xr.dtype)


def setup_inputs(seed: int = 0) -> dict:
    key = jax.random.key(seed)
    ks = jax.random.split(key, 20)
    f32 = jnp.float32

    def nrm(k, shape, scale):
        return jax.random.normal(k, shape, f32) * scale

    x = nrm(ks[0], (BATCH, SEQ, D_MODEL), 1.0)
    w_in = nrm(ks[1], (DEPTH, D_MODEL, IN_COLS), D_MODEL ** -0.5)
    w_o_attn = nrm(ks[2], (DEPTH, Q_DIM, D_MODEL), Q_DIM ** -0.5)
    w_o_lru = nrm(ks[3], (DEPTH, LRU_WIDTH, D_MODEL), LRU_WIDTH ** -0.5)
    w_out = nrm(ks[4], (DEPTH, D_MODEL, D_MODEL), D_MODEL ** -0.5)
    attn_sink = nrm(ks[5], (DEPTH, N_HEADS), 0.5)
    rel_bias = nrm(ks[6], (NUM_BUCKETS, N_HEADS), 0.5)
    conv_w = nrm(ks[7], (DEPTH, CONV_WIDTH, LRU_WIDTH), CONV_WIDTH ** -0.5)
    conv_b = nrm(ks[8], (DEPTH, LRU_WIDTH), 0.02)
    w_rgate = nrm(ks[9], (DEPTH, N_DIRS, LRU_BLOCKS, LRU_BLOCK_DIM, LRU_BLOCK_DIM), LRU_BLOCK_DIM ** -0.5)
    b_rgate = nrm(ks[10], (DEPTH, N_DIRS, LRU_WIDTH), 0.02)
    w_igate = nrm(ks[11], (DEPTH, N_DIRS, LRU_BLOCKS, LRU_BLOCK_DIM, LRU_BLOCK_DIM), LRU_BLOCK_DIM ** -0.5)
    b_igate = nrm(ks[12], (DEPTH, N_DIRS, LRU_WIDTH), 0.02)
    a_c = jax.random.uniform(ks[13], (DEPTH, N_DIRS, LRU_WIDTH), f32, 0.9, 0.999)
    a = a_c ** (1.0 / LRU_C)
    lru_lambda = jnp.log(a) - jnp.log1p(-a)
    norm1_g = 1.0 + nrm(ks[14], (DEPTH, D_MODEL), 0.02)
    norm2_g = 1.0 + nrm(ks[15], (DEPTH, D_MODEL), 0.02)
    w_mlp_up = nrm(ks[16], (DEPTH, D_MODEL, D_FF), D_MODEL ** -0.5)
    w_mlp_down = nrm(ks[17], (DEPTH, D_FF, D_MODEL), 0.5 * D_FF ** -0.5)
    final_norm_g = 1.0 + nrm(ks[18], (D_MODEL,), 0.02)
    return {"x": x, "w_in": w_in, "w_o_attn": w_o_attn, "w_o_lru": w_o_lru, "w_out": w_out,
            "attn_sink": attn_sink, "rel_bias": rel_bias, "conv_w": conv_w, "conv_b": conv_b,
            "w_rgate": w_rgate, "b_rgate": b_rgate, "w_igate": w_igate, "b_igate": b_igate,
            "lru_lambda": lru_lambda, "norm1_g": norm1_g, "norm2_g": norm2_g,
            "w_mlp_up": w_mlp_up, "w_mlp_down": w_mlp_down, "final_norm_g": final_norm_g}


def reference(x, w_in, w_o_attn, w_o_lru, w_out, attn_sink, rel_bias, conv_w, conv_b,
              w_rgate, b_rgate, w_igate, b_igate, lru_lambda, norm1_g, norm2_g,
              w_mlp_up, w_mlp_down, final_norm_g):
    cuts = np.cumsum(SPLITS)[:-1].tolist()
    for l in range(DEPTH):
        h = rms_norm(x, norm1_g[l])
        q, k, v, xr, gr, ga, gb = jnp.split(h @ w_in[l], cuts, axis=-1)
        ya = windowed_gqa(q, k, v, attn_sink[l], rel_bias) @ w_o_attn[l]
        yb = rg_lru_bidir(xr, gr, conv_w[l], conv_b[l], w_rgate[l], b_rgate[l],
                          w_igate[l], b_igate[l], lru_lambda[l]) @ w_o_lru[l]
        mix = jax.nn.sigmoid(ga) * ya + jax.nn.sigmoid(gb) * yb
        x = x + mix @ w_out[l]
        h = rms_norm(x, norm2_g[l])
        x = x + jnp.square(jax.nn.relu(h @ w_mlp_up[l])) @ w_mlp_down[l]
    return rms_norm(x, final_norm_g)
```

```cpp
#include <hip/hip_runtime.h>
#include <hip/hip_cooperative_groups.h>
#include <cstdio>
#include <cstdint>
namespace cg = cooperative_groups;

#define LAS __attribute__((address_space(3)))
typedef unsigned short bf16_t;
typedef short bf16x8 __attribute__((ext_vector_type(8)));
typedef short s16x4 __attribute__((ext_vector_type(4)));
typedef float f32x2 __attribute__((ext_vector_type(2)));
typedef float f32x4 __attribute__((ext_vector_type(4)));
typedef float f32x16 __attribute__((ext_vector_type(16)));
typedef unsigned u32x2 __attribute__((ext_vector_type(2)));
typedef unsigned u32x4 __attribute__((ext_vector_type(4)));
typedef __bf16 bf16x2n __attribute__((ext_vector_type(2)));

constexpr int BATCH = 8, SEQ = 8192, D = 1024, DEPTH = 4, NIN = 5632, FF = 4096;
constexpr int M = BATCH * SEQ;
constexpr float LOG2E = 1.4426950408889634f;
constexpr float QSCALE = 0.08838834764831845f * LOG2E;
constexpr int LRU_T = 64, LRU_NCH = SEQ / LRU_T;

constexpr size_t MiB = 1u << 20;
constexpr size_t WS_WIN = 0, WS_WOA = 44 * MiB, WS_WOL = 52 * MiB, WS_WOUT = 60 * MiB, WS_WUP = 68 * MiB, WS_WDN = 100 * MiB, WS_WG = 132 * MiB;
constexpr size_t WS_MISC = 136 * MiB, WS_SS = 137 * MiB, WS_AGG = 141 * MiB, WS_CARRY = 157 * MiB, WS_XB = 165 * MiB, WS_P = 293 * MiB;
constexpr size_t P_Q = 0, P_KV = (size_t)M * 1024, P_XR = P_KV + (size_t)M * 512, P_GR = P_XR + (size_t)M * 1024, P_GA = P_GR + (size_t)M * 1024, P_GB = P_GA + (size_t)M * 1024;
constexpr size_t WS_END = WS_P + (P_GB + (size_t)M * 1024) * 2;
static_assert(WS_END == 997 * MiB, "ws map");
constexpr int LDS_BYTES = 147456;

__device__ __forceinline__ unsigned pk2(float a, float b) { f32x2 v = {a, b}; bf16x2n r = __builtin_convertvector(v, bf16x2n); return __builtin_bit_cast(unsigned, r); }
__device__ __forceinline__ float bflo(unsigned u) { return __builtin_bit_cast(float, u << 16); }
__device__ __forceinline__ float bfhi(unsigned u) { return __builtin_bit_cast(float, u & 0xffff0000u); }
__device__ __forceinline__ float sigmoidf_(float x) { return __builtin_amdgcn_rcpf(1.f + __expf(-x)); }

namespace pg8 {
constexpr int BM = 256, BK = 64, HALF = 128, HTB = HALF * BK * 2, STAGE_BYTES = 8 * HTB, NXCD = 8, WGM = 8;
__host__ __device__ __forceinline__ int lds_byte(int r, int c) { const int st = (r >> 4) * 2 + (c >> 5), rr = r & 15, cc = c & 31, ob = rr * 64 + cc * 2; return st * 1024 + (ob ^ (((ob >> 9) & 1) << 5)); }
__host__ __device__ __forceinline__ void stage_rc(int b, int& R, int& C) { const int st = b / 1024, sb = b % 1024, swz = sb ^ (((sb >> 9) & 1) << 5); R = (st >> 1) * 16 + swz / 64; C = (st & 1) * 32 + (swz % 64) / 2; }
__host__ __device__ __forceinline__ int perm32(int rho) { const int n = rho >> 4, i = rho & 15; return 8 * (i >> 2) + 4 * n + (i & 3); }

struct Unit { int pm, pn; };
struct Gemm { const bf16_t* A; const bf16_t* Bt; int M, N, K; };

struct StaticOrder {
    int nM, nN, nwg, G, c;
    __host__ __device__ void init(int M_, int N_, int G_, int c_) { nM = M_ / BM; nN = N_ / BM; nwg = nM * nN; G = G_; c = c_; }
    __host__ __device__ bool next(int i, Unit& u) const {
        const long L = (long)i * G + c; if (L >= nwg) return false;
        int wgid = (int)L; { const int q = nwg / NXCD, r = nwg % NXCD, xcd = wgid % NXCD, off = wgid / NXCD; wgid = (xcd < r ? xcd * (q + 1) : r * (q + 1) + (xcd - r) * q) + off; }
        const int nig = WGM * nN, gid = wgid / nig, fm = gid * WGM, gsz = (nM - fm) < WGM ? (nM - fm) : WGM;
        u.pm = fm + ((wgid % nig) % gsz); u.pn = (wgid % nig) / gsz; return true;
    }
};

__device__ __forceinline__ float row_rstd(const float* ss, int row) {
    const f32x4* p = (const f32x4*)(ss + (size_t)row * 16);
    const f32x4 a = p[0], b = p[1], c = p[2], d = p[3];
    const float s = (((a.x + a.y) + (a.z + a.w)) + ((b.x + b.y) + (b.z + b.w))) + (((c.x + c.y) + (c.z + c.w)) + ((d.x + d.y) + (d.z + d.w)));
    return __builtin_amdgcn_rsqf(s * (1.f / 1024.f) + 1e-6f);
}

struct EpiIn {
    static constexpr bool PERM = true;
    bf16_t* P; const float* ss;
    __device__ __forceinline__ void operator()(const f32x4 (&acc)[2][2][4][2], const Unit& u, int wr, int wc, int fr, int fq) const {
        const int pn = u.pn; bf16_t* base; int ld; float sc = 1.f;
        if (pn < 4) { base = P + P_Q + pn * 256; ld = 1024; sc = QSCALE; }
        else if (pn < 6) { base = P + P_KV + (pn - 4) * 256; ld = 512; }
        else { const int t = (pn - 6) >> 2, c = (pn - 6) & 3; base = P + P_XR + (size_t)t * ((size_t)M * 1024) + c * 256; ld = 1024; }
        const int row0 = u.pm * BM + wr * 64 + fr, col0 = wc * 32 + 8 * fq;
#pragma unroll
        for (int ai = 0; ai < 2; ++ai)
#pragma unroll
            for (int m = 0; m < 4; ++m) { const int row = row0 + ai * HALF + m * 16; const float rs = row_rstd(ss, row) * sc; bf16_t* rowp = base + (size_t)row * ld + col0;
#pragma unroll
                for (int bj = 0; bj < 2; ++bj) { const f32x4 v0 = acc[ai][bj][m][0] * rs, v1 = acc[ai][bj][m][1] * rs;
                    u32x4 w; w.x = pk2(v0[0], v0[1]); w.y = pk2(v0[2], v0[3]); w.z = pk2(v1[0], v1[1]); w.w = pk2(v1[2], v1[3]);
                    *(u32x4*)(rowp + bj * HALF) = w; } }
    }
};
struct EpiUp {
    static constexpr bool PERM = true;
    bf16_t* U; const float* ss;
    __device__ __forceinline__ void operator()(const f32x4 (&acc)[2][2][4][2], const Unit& u, int wr, int wc, int fr, int fq) const {
        const int row0 = u.pm * BM + wr * 64 + fr, col0 = u.pn * BM + wc * 32 + 8 * fq;
#pragma unroll
        for (int ai = 0; ai < 2; ++ai)
#pragma unroll
            for (int m = 0; m < 4; ++m) { const int row = row0 + ai * HALF + m * 16; const float rs = row_rstd(ss, row); bf16_t* rowp = U + (size_t)row * FF + col0;
#pragma unroll
                for (int bj = 0; bj < 2; ++bj) { f32x4 v0 = acc[ai][bj][m][0] * rs, v1 = acc[ai][bj][m][1] * rs;
#pragma unroll
                    for (int j = 0; j < 4; ++j) { const float a = fmaxf(v0[j], 0.f), b = fmaxf(v1[j], 0.f); v0[j] = a * a; v1[j] = b * b; }
                    u32x4 w; w.x = pk2(v0[0], v0[1]); w.y = pk2(v0[2], v0[3]); w.z = pk2(v1[0], v1[1]); w.w = pk2(v1[2], v1[3]);
                    *(u32x4*)(rowp + bj * HALF) = w; } }
    }
};
template <int STAGE> struct EpiGate {
    static constexpr bool PERM = true;
    bf16_t* GA; const bf16_t* GB;
    __device__ __forceinline__ void operator()(const f32x4 (&acc)[2][2][4][2], const Unit& u, int wr, int wc, int fr, int fq) const {
        const int row0 = u.pm * BM + wr * 64 + fr, col0 = u.pn * BM + wc * 32 + 8 * fq;
#pragma unroll
        for (int ai = 0; ai < 2; ++ai)
#pragma unroll
            for (int m = 0; m < 4; ++m) { const size_t off = (size_t)(row0 + ai * HALF + m * 16) * 1024 + col0;
#pragma unroll
                for (int bj = 0; bj < 2; ++bj) {
                    const u32x4 g = *(const u32x4*)((STAGE == 0 ? (const bf16_t*)GA : GB) + off + bj * HALF);
                    float s[8] = {bflo(g.x), bfhi(g.x), bflo(g.y), bfhi(g.y), bflo(g.z), bfhi(g.z), bflo(g.w), bfhi(g.w)};
                    float o[8];
#pragma unroll
                    for (int j = 0; j < 8; ++j) o[j] = sigmoidf_(s[j]) * acc[ai][bj][m][j >> 2][j & 3];
                    if (STAGE == 1) { const u32x4 t = *(const u32x4*)(GA + off + bj * HALF);
                        o[0] += bflo(t.x); o[1] += bfhi(t.x); o[2] += bflo(t.y); o[3] += bfhi(t.y); o[4] += bflo(t.z); o[5] += bfhi(t.z); o[6] += bflo(t.w); o[7] += bfhi(t.w); }
                    u32x4 w; w.x = pk2(o[0], o[1]); w.y = pk2(o[2], o[3]); w.z = pk2(o[4], o[5]); w.w = pk2(o[6], o[7]);
                    *(u32x4*)(GA + off + bj * HALF) = w; } }
    }
};
struct EpiRes {
    static constexpr bool PERM = false;
    const float* res; float* out; bf16_t* xb; float* ss;
    __device__ __forceinline__ void operator()(const f32x4 (&acc)[2][2][4][2], const Unit& u, int wr, int wc, int fr, int fq) const {
        const int row0 = u.pm * BM + wr * 64 + fr, col0 = u.pn * BM + wc * 32 + 4 * fq;
#pragma unroll
        for (int ai = 0; ai < 2; ++ai)
#pragma unroll
            for (int m = 0; m < 4; ++m) { const int row = row0 + ai * HALF + m * 16; const size_t off = (size_t)row * 1024 + col0; float sq = 0.f;
#pragma unroll
                for (int bj = 0; bj < 2; ++bj)
#pragma unroll
                    for (int n = 0; n < 2; ++n) { const f32x4 r = *(const f32x4*)(res + off + bj * HALF + n * 16); const f32x4 o = r + acc[ai][bj][m][n];
                        *(f32x4*)(out + off + bj * HALF + n * 16) = o;
                        u32x2 w; w.x = pk2(o[0], o[1]); w.y = pk2(o[2], o[3]); *(u32x2*)(xb + off + bj * HALF + n * 16) = w;
                        sq += (o[0] * o[0] + o[1] * o[1]) + (o[2] * o[2] + o[3] * o[3]); }
                sq += __shfl_xor(sq, 16); sq += __shfl_xor(sq, 32);
                if (fq == 0) ss[(size_t)row * 16 + u.pn * 4 + wc] = sq; }
    }
};

template <class Epi>
__device__ __forceinline__ void gemm_phase(LAS unsigned char* lds, const Gemm g, const StaticOrder& S, const Epi& E) {
    int tid = threadIdx.x; asm volatile("" : "+v"(tid));
    const int wid = __builtin_amdgcn_readfirstlane(tid >> 6), lane = tid & 63, wr = wid >> 2, wc = wid & 3, fr = lane & 15, fq = lane >> 4;
    const int K = g.K, nt = K / BK;
    unsigned voffA[2], voffB[2];
#pragma unroll
    for (int i = 0; i < 2; ++i) { int R, C; stage_rc(tid * 16 + i * 8192, R, C); const int Rb = Epi::PERM ? ((R & ~31) + perm32(R & 31)) : R;
        voffA[i] = (unsigned)(R * K + C) * 2u; voffB[i] = (unsigned)(Rb * K + C) * 2u; }
    const size_t kstep = (size_t)(BK * 2);
    const size_t hstep = (size_t)HALF * K * 2;
    const size_t tstep = 2 * hstep;
    const unsigned ldsw = (unsigned)wid * 1024u;
    const int aoff = lds_byte(wr * 64 + fr, fq * 8), boff = lds_byte(wc * 32 + fr, fq * 8);
#define PG8_SA(b, h) (((b) * 2 + (h)) * HTB)
#define PG8_SB(b, h) ((4 + (b) * 2 + (h)) * HTB)
#define PG8_STAGE(bufoff, gbase, voff) do { _Pragma("unroll") for (int _i = 0; _i < 2; ++_i) \
        __builtin_amdgcn_global_load_lds((const unsigned*)((const char*)(gbase) + (voff)[_i]), (LAS unsigned*)(lds + (bufoff) + ldsw + _i * 8192), 16, 0, 0); } while (0)
#define PG8_LDA(dst, b, h) do { _Pragma("unroll") for (int m = 0; m < 4; ++m) _Pragma("unroll") for (int k = 0; k < 2; ++k) dst[m][k] = *(const LAS bf16x8*)(lds + PG8_SA(b, h) + aoff + m * 2048 + k * 1024); } while (0)
#define PG8_LDB(dst, b, h) do { _Pragma("unroll") for (int n = 0; n < 2; ++n) _Pragma("unroll") for (int k = 0; k < 2; ++k) dst[n][k] = *(const LAS bf16x8*)(lds + PG8_SB(b, h) + boff + n * 2048 + k * 1024); } while (0)
#define PG8_MMA(ai, bj, At, Bt) do { __builtin_amdgcn_s_setprio(1); _Pragma("unroll") for (int m = 0; m < 4; ++m) _Pragma("unroll") for (int n = 0; n < 2; ++n) _Pragma("unroll") for (int k = 0; k < 2; ++k) \
        acc[ai][bj][m][n] = __builtin_amdgcn_mfma_f32_16x16x32_bf16(Bt[n][k], At[m][k], acc[ai][bj][m][n], 0, 0, 0); __builtin_amdgcn_s_setprio(0); } while (0)
#define PG8_WAIT_V(n) asm volatile("s_waitcnt vmcnt(" #n ")" ::: "memory")
#define PG8_WAIT_L(n) asm volatile("s_waitcnt lgkmcnt(" #n ")" ::: "memory")
#define PG8_BAR __builtin_amdgcn_s_barrier()
#define PG8_SCHED __builtin_amdgcn_sched_barrier(0)
    Unit cur, nxt; int ui = 0;
    if (!S.next(0, cur)) return;
    f32x4 acc[2][2][4][2];
#pragma unroll
    for (int a = 0; a < 2; ++a)
#pragma unroll
        for (int b = 0; b < 2; ++b)
#pragma unroll
            for (int m = 0; m < 4; ++m)
#pragma unroll
                for (int n = 0; n < 2; ++n) acc[a][b][m][n] = (f32x4){0.f, 0.f, 0.f, 0.f};
    bf16x8 At[4][2], B0[2][2], B1[2][2];
    const char* cA = (const char*)g.A + (size_t)cur.pm * tstep; const char* cB = (const char*)g.Bt + (size_t)cur.pn * tstep;
    PG8_STAGE(PG8_SB(0, 0), cB, voffB); PG8_STAGE(PG8_SB(0, 1), cB + hstep, voffB); PG8_STAGE(PG8_SA(0, 0), cA, voffA); PG8_STAGE(PG8_SA(0, 1), cA + hstep, voffA);
    if (wr == 1) PG8_BAR;
    PG8_WAIT_V(2); PG8_BAR;
    PG8_STAGE(PG8_SB(1, 0), cB + kstep, voffB); PG8_STAGE(PG8_SA(1, 0), cA + kstep, voffA); PG8_STAGE(PG8_SB(1, 1), cB + hstep + kstep, voffB);
    PG8_WAIT_V(6); PG8_BAR;
    for (;;) {
        const bool has_next = S.next(ui + 1, nxt);
        const char* nA = has_next ? (const char*)g.A + (size_t)nxt.pm * tstep : cA; const char* nB = has_next ? (const char*)g.Bt + (size_t)nxt.pn * tstep : cB;
        for (int t = 0; t < nt; t += 2) {
            const bool last = (t == nt - 2);
            const char* a1 = cA + (size_t)(t + 1) * kstep;
            const char* a2 = last ? nA : cA + (size_t)(t + 2) * kstep; const char* b2 = last ? nB : cB + (size_t)(t + 2) * kstep;
            const char* a3 = a2 + kstep; const char* b3 = b2 + kstep;
            PG8_LDB(B0, 0, 0); PG8_LDB(B1, 0, 1); PG8_SCHED; PG8_LDA(At, 0, 0); PG8_STAGE(PG8_SA(1, 1), a1 + hstep, voffA);
            PG8_WAIT_V(8); PG8_WAIT_L(0); PG8_BAR; PG8_MMA(0, 0, At, B0); PG8_MMA(0, 1, At, B1); PG8_BAR; PG8_SCHED;
            PG8_LDA(At, 0, 1); PG8_STAGE(PG8_SB(0, 0), b2, voffB); PG8_STAGE(PG8_SB(0, 1), b2 + hstep, voffB); PG8_STAGE(PG8_SA(0, 0), a2, voffA);
            PG8_WAIT_V(8); PG8_WAIT_L(0); PG8_BAR; PG8_MMA(1, 0, At, B0); PG8_MMA(1, 1, At, B1); PG8_BAR; PG8_SCHED;
            PG8_LDB(B0, 1, 0); PG8_LDB(B1, 1, 1); PG8_SCHED; PG8_LDA(At, 1, 0); PG8_STAGE(PG8_SA(0, 1), a2 + hstep, voffA);
            PG8_WAIT_V(8); PG8_WAIT_L(0); PG8_BAR; PG8_MMA(0, 0, At, B0); PG8_MMA(0, 1, At, B1); PG8_BAR; PG8_SCHED;
            PG8_LDA(At, 1, 1); PG8_STAGE(PG8_SB(1, 0), b3, voffB); PG8_STAGE(PG8_SB(1, 1), b3 + hstep, voffB); PG8_STAGE(PG8_SA(1, 0), a3, voffA);
            PG8_WAIT_V(8); PG8_WAIT_L(0); PG8_BAR; PG8_MMA(1, 0, At, B0); PG8_MMA(1, 1, At, B1); PG8_BAR; PG8_SCHED;
        }
        if (wr == 0) PG8_BAR;
        E(acc, cur, wr, wc, fr, fq);
        if (!has_next) break;
#pragma unroll
        for (int a = 0; a < 2; ++a)
#pragma unroll
            for (int b = 0; b < 2; ++b)
#pragma unroll
                for (int m = 0; m < 4; ++m)
#pragma unroll
                    for (int n = 0; n < 2; ++n) acc[a][b][m][n] = (f32x4){0.f, 0.f, 0.f, 0.f};
        cur = nxt; cA = nA; cB = nB; ++ui;
        if (wr == 1) PG8_BAR;
    }
    PG8_WAIT_V(0);
    PG8_BAR;
#undef PG8_SA
#undef PG8_SB
#undef PG8_STAGE
#undef PG8_LDA
#undef PG8_LDB
#undef PG8_MMA
#undef PG8_WAIT_V
#undef PG8_WAIT_L
#undef PG8_BAR
#undef PG8_SCHED
}
}

struct Args { const float* in[19]; float* out; unsigned char* ws; };

__device__ __forceinline__ float wave_sum(float v) {
#pragma unroll
    for (int o = 1; o < 64; o <<= 1) v += __shfl_xor(v, o);
    return v;
}

__device__ __forceinline__ void transpose_item(const float* W, int K, int N, bf16_t* WT, const float* gain, LAS float* scr, int item, int lane) {
    const int nblk = N / 32, kb = item / nblk, nb = item % nblk, k0 = 64 * kb, n0 = 32 * nb;
#pragma unroll 8
    for (int i = 0; i < 32; ++i) { const int kk = 2 * i + (lane >> 5); float v = W[(size_t)(k0 + kk) * N + n0 + (lane & 31)]; if (gain) v *= gain[k0 + kk]; scr[kk * 33 + (lane & 31)] = v; }
    asm volatile("s_waitcnt lgkmcnt(0)" ::: "memory");
    const int c = lane & 7;
#pragma unroll
    for (int j = 0; j < 4; ++j) { const int n = (lane >> 3) + 8 * j; const LAS float* s = scr + (8 * c) * 33 + n;
        u32x4 o; o.x = pk2(s[0 * 33], s[1 * 33]); o.y = pk2(s[2 * 33], s[3 * 33]); o.z = pk2(s[4 * 33], s[5 * 33]); o.w = pk2(s[6 * 33], s[7 * 33]);
        *(u32x4*)(WT + (size_t)(n0 + n) * K + k0 + 8 * c) = o; }
    asm volatile("s_waitcnt lgkmcnt(0)" ::: "memory");
}
__device__ __forceinline__ void transpose_all(const float* W, int K, int N, bf16_t* WT, const float* gain, LAS float* scr, int gw, int NGW, int lane) {
    const int items = (K / 64) * (N / 32);
    for (int it = gw; it < items; it += NGW) transpose_item(W, K, N, WT, gain, scr, it, lane);
}

__device__ __forceinline__ int t5_bucket(int rel) {
    const int n = rel < 0 ? -rel : rel; int bk;
    if (n < 8) bk = n; else { int j = (31 - __clz(n * n)) - 6; bk = 8 + j; if (bk > 15) bk = 15; }
    return bk + (rel > 0 ? 16 : 0);
}

constexpr int KP = 272;
__device__ __forceinline__ void attn_phase(LAS unsigned char* lds, bf16_t* Q, const bf16_t* KV, const float* biasT, const float* sink, int G, int wg) {
    int tid = threadIdx.x; asm volatile("" : "+v"(tid));
    const int wave = __builtin_amdgcn_readfirstlane(tid >> 6), lane = tid & 63, r = lane & 31, h = lane >> 5;
    LAS unsigned char* Kb = lds; LAS unsigned char* Vb = lds + 128 * KP; LAS float* bt = (LAS float*)(lds + 2 * 128 * KP);
    const int qt = wave & 3, hl = wave >> 2;
    for (int item = wg; item < BATCH * 64 * 4; item += G) {
        const int hp = item & 1, kvh = (item >> 1) & 1, qi = (item >> 2) & 63, b = item >> 8;
        const int head = kvh * 4 + hp * 2 + hl;
        __syncthreads();
        for (int e = tid; e < 1024; e += 512) bt[e] = biasT[(kvh * 4 + hp * 2 + (e >> 9)) * 512 + (e & 511)];
        const size_t qrow = (size_t)b * SEQ + qi * 128 + qt * 32 + r;
        bf16x8 qf[8];
#pragma unroll
        for (int ks = 0; ks < 8; ++ks) qf[ks] = *(const bf16x8*)(Q + qrow * 1024 + head * 128 + 16 * ks + 8 * h);
        const float sink2 = sink[head] * LOG2E;
        float mrun = sink2, lrun = 0.f;
        f32x16 O[4];
#pragma unroll
        for (int dt = 0; dt < 4; ++dt)
#pragma unroll
            for (int i = 0; i < 16; ++i) O[dt][i] = 0.f;
        for (int kb = -1; kb <= 1; ++kb) {
            const int kblk = qi + kb; if (kblk < 0 || kblk >= 64) continue;
            __syncthreads();
            { const bf16_t* kbase = KV + ((size_t)b * SEQ + kblk * 128) * 512 + kvh * 128;
#pragma unroll
              for (int c = 0; c < 4; ++c) { const int ch = tid + 512 * c, row = ch >> 4, c16 = ch & 15;
                  const u32x4 kk = *(const u32x4*)(kbase + (size_t)row * 512 + c16 * 8); const u32x4 vv = *(const u32x4*)(kbase + (size_t)row * 512 + 256 + c16 * 8);
                  *(LAS u32x4*)(Kb + row * KP + c16 * 16) = kk; *(LAS u32x4*)(Vb + row * KP + c16 * 16) = vv; } }
            __syncthreads();
#pragma unroll 1
            for (int sub = 0; sub < 2; ++sub) {
                if (kb == -1 && sub == 0 && qt >= 2) continue;
                if (kb == 1 && sub == 1 && qt <= 1) continue;
                f32x16 sa[2];
#pragma unroll
                for (int kt = 0; kt < 2; ++kt) {
#pragma unroll
                    for (int i = 0; i < 16; ++i) sa[kt][i] = 0.f;
#pragma unroll
                    for (int ks = 0; ks < 8; ++ks) { const bf16x8 kf = *(const LAS bf16x8*)(Kb + (64 * sub + 32 * kt + r) * KP + (16 * ks + 8 * h) * 2);
                        sa[kt] = __builtin_amdgcn_mfma_f32_32x32x16_bf16(kf, qf[ks], sa[kt], 0, 0, 0); } }
                const LAS float* btl = bt + hl * 512 + (kb * 128 + 64 * sub + 4 * h - 32 * qt - r + 256);
                float mx = -3.0e38f;
#pragma unroll
                for (int kt = 0; kt < 2; ++kt)
#pragma unroll
                    for (int i = 0; i < 16; ++i) { const float s = sa[kt][i] + btl[32 * kt + (i & 3) + 8 * (i >> 2)]; sa[kt][i] = s; mx = fmaxf(mx, s); }
                mx = fmaxf(mx, __shfl_xor(mx, 32));
                const float mnew = fmaxf(mrun, mx), alpha = __builtin_amdgcn_exp2f(mrun - mnew);
                mrun = mnew; lrun *= alpha;
#pragma unroll
                for (int dt = 0; dt < 4; ++dt)
#pragma unroll
                    for (int i = 0; i < 16; ++i) O[dt][i] *= alpha;
                float ls = 0.f;
#pragma unroll
                for (int kt = 0; kt < 2; ++kt)
#pragma unroll
                    for (int i = 0; i < 16; ++i) { const float p = __builtin_amdgcn_exp2f(sa[kt][i] - mnew); sa[kt][i] = p; ls += p; }
                lrun += ls;
#pragma unroll
                for (int kt = 0; kt < 2; ++kt)
#pragma unroll
                    for (int s2 = 0; s2 < 2; ++s2) {
                        u32x4 pw; pw.x = pk2(sa[kt][8 * s2 + 0], sa[kt][8 * s2 + 1]); pw.y = pk2(sa[kt][8 * s2 + 2], sa[kt][8 * s2 + 3]); pw.z = pk2(sa[kt][8 * s2 + 4], sa[kt][8 * s2 + 5]); pw.w = pk2(sa[kt][8 * s2 + 6], sa[kt][8 * s2 + 7]);
                        const bf16x8 pf = __builtin_bit_cast(bf16x8, pw);
                        const int key0 = 64 * sub + 32 * kt + 16 * s2 + 4 * h + ((lane & 15) >> 2);
                        const LAS unsigned char* vp = Vb + key0 * KP + ((lane >> 4) & 1) * 32 + (lane & 3) * 8;
#pragma unroll
                        for (int dt = 0; dt < 4; ++dt) {
                            const s16x4 lo = __builtin_amdgcn_ds_read_tr16_b64_v4i16((LAS s16x4*)(vp + dt * 64));
                            const s16x4 hi = __builtin_amdgcn_ds_read_tr16_b64_v4i16((LAS s16x4*)(vp + 8 * KP + dt * 64));
                            const bf16x8 va = __builtin_shufflevector(lo, hi, 0, 1, 2, 3, 4, 5, 6, 7);
                            O[dt] = __builtin_amdgcn_mfma_f32_32x32x16_bf16(va, pf, O[dt], 0, 0, 0); } }
            }
        }
        const float ltot = lrun + __shfl_xor(lrun, 32) + __builtin_amdgcn_exp2f(sink2 - mrun);
        const float inv = 1.f / ltot;
        bf16_t* orow = Q + qrow * 1024 + head * 128 + 4 * h;
#pragma unroll
        for (int dt = 0; dt < 4; ++dt)
#pragma unroll
            for (int g4 = 0; g4 < 4; ++g4) { u32x2 w; w.x = pk2(O[dt][4 * g4] * inv, O[dt][4 * g4 + 1] * inv); w.y = pk2(O[dt][4 * g4 + 2] * inv, O[dt][4 * g4 + 3] * inv);
                *(u32x2*)(orow + 32 * dt + 8 * g4) = w; }
    }
    __syncthreads();
}

constexpr int XCB_P = 272, XCF_P = 132;
constexpr int LRU_XCB = 0, LRU_XCF = 64 * XCB_P, LRU_Y = LRU_XCF + 64 * XCF_P * 4;
__device__ __forceinline__ float neg_expm1(float x) {
    if (x < -0.25f) return 1.f - __expf(x);
    float p = 1.f + x * (1.f / 7.f); p = 1.f + x * (1.f / 6.f) * p; p = 1.f + x * (1.f / 5.f) * p; p = 1.f + x * 0.25f * p; p = 1.f + x * (1.f / 3.f) * p; p = 1.f + x * 0.5f * p;
    return -x * p;
}
template <int PASS>
__device__ __forceinline__ void lru_phase(LAS unsigned char* lds, const bf16_t* XR, bf16_t* GR, const float* conv_w, const float* conv_b, const bf16_t* WG, const float* b_r, const float* b_i,
                                          const float* lam, f32x2* agg, const float* carry, int G, int wg) {
    int tid = threadIdx.x; asm volatile("" : "+v"(tid));
    const int wave = __builtin_amdgcn_readfirstlane(tid >> 6), lane = tid & 63, chl = lane & 15, qd = lane >> 4;
    LAS unsigned char* xcb = lds + LRU_XCB; LAS float* xcf = (LAS float*)(lds + LRU_XCF); LAS float* yb = (LAS float*)(lds + LRU_Y);
    for (int tile = wg; tile < BATCH * LRU_NCH * 8; tile += G) {
        const int n = tile & 7, c = (tile >> 3) & (LRU_NCH - 1), b = tile >> 10;
        const int t0 = c * LRU_T; const size_t row0 = (size_t)b * SEQ + t0;
        __syncthreads();
#pragma unroll
        for (int i = 0; i < 2; ++i) { const int e = tid + 512 * i, t = e >> 4, c8 = e & 15, ch0 = n * 128 + c8 * 8;
            float xc[8];
            { const f32x4 b0 = *(const f32x4*)(conv_b + ch0), b1 = *(const f32x4*)(conv_b + ch0 + 4); xc[0] = b0.x; xc[1] = b0.y; xc[2] = b0.z; xc[3] = b0.w; xc[4] = b1.x; xc[5] = b1.y; xc[6] = b1.z; xc[7] = b1.w; }
#pragma unroll
            for (int j = 0; j < 4; ++j) { const int s = t0 + t + j - 2;
                if (s >= 0 && s < SEQ) { const u32x4 xv = *(const u32x4*)(XR + ((size_t)b * SEQ + s) * 1024 + ch0);
                    const f32x4 w0 = *(const f32x4*)(conv_w + j * 1024 + ch0), w1 = *(const f32x4*)(conv_w + j * 1024 + ch0 + 4);
                    xc[0] += bflo(xv.x) * w0.x; xc[1] += bfhi(xv.x) * w0.y; xc[2] += bflo(xv.y) * w0.z; xc[3] += bfhi(xv.y) * w0.w;
                    xc[4] += bflo(xv.z) * w1.x; xc[5] += bfhi(xv.z) * w1.y; xc[6] += bflo(xv.w) * w1.z; xc[7] += bfhi(xv.w) * w1.w; } }
            *(LAS f32x4*)(xcf + t * XCF_P + c8 * 8) = (f32x4){xc[0], xc[1], xc[2], xc[3]}; *(LAS f32x4*)(xcf + t * XCF_P + c8 * 8 + 4) = (f32x4){xc[4], xc[5], xc[6], xc[7]};
            u32x4 w; w.x = pk2(xc[0], xc[1]); w.y = pk2(xc[2], xc[3]); w.z = pk2(xc[4], xc[5]); w.w = pk2(xc[6], xc[7]);
            *(LAS u32x4*)(xcb + t * XCB_P + c8 * 16) = w; }
        __syncthreads();
        f32x4 acc[4][4];
#pragma unroll
        for (int g = 0; g < 4; ++g)
#pragma unroll
            for (int mt = 0; mt < 4; ++mt) acc[g][mt] = (f32x4){0.f, 0.f, 0.f, 0.f};
        const int chb = 16 * wave + chl;
#pragma unroll
        for (int ks = 0; ks < 4; ++ks) {
            bf16x8 af[4], bfr[4];
#pragma unroll
            for (int mt = 0; mt < 4; ++mt) { const int tok = (chl >> 2) * 16 + 4 * mt + (chl & 3); af[mt] = *(const LAS bf16x8*)(xcb + tok * XCB_P + (32 * ks + 8 * qd) * 2); }
#pragma unroll
            for (int g = 0; g < 4; ++g) bfr[g] = *(const bf16x8*)(WG + ((size_t)(g * 8 + n) * 128 + chb) * 128 + 32 * ks + 8 * qd);
#pragma unroll
            for (int g = 0; g < 4; ++g)
#pragma unroll
                for (int mt = 0; mt < 4; ++mt) acc[g][mt] = __builtin_amdgcn_mfma_f32_16x16x32_bf16(af[mt], bfr[g], acc[g][mt], 0, 0, 0);
        }
        const int ch = n * 128 + chb;
#pragma unroll
        for (int d = 0; d < 2; ++d) {
            const float br = b_r[d * 1024 + ch], bi = b_i[d * 1024 + ch], cl = -8.f * log1pf(expf(-lam[d * 1024 + ch]));
#pragma unroll
            for (int mt = 0; mt < 4; ++mt)
#pragma unroll
                for (int j = 0; j < 4; ++j) { const float x = xcf[(qd * 16 + 4 * mt + j) * XCF_P + chb];
                    const float rg = sigmoidf_(acc[2 * d][mt][j] + br), ig = sigmoidf_(acc[2 * d + 1][mt][j] + bi);
                    const float la = rg * cl, a = __expf(la), mult = __builtin_sqrtf(neg_expm1(2.f * la));
                    acc[2 * d][mt][j] = a; acc[2 * d + 1][mt][j] = mult * ig * x; }
        }
        float Af = 1.f, Hf = 0.f, Ab = 1.f, Hb = 0.f;
#pragma unroll
        for (int k = 0; k < 16; ++k) { const float a = acc[0][k >> 2][k & 3], u = acc[1][k >> 2][k & 3]; Af *= a; Hf = a * Hf + u; }
#pragma unroll
        for (int k = 15; k >= 0; --k) { const float a = acc[2][k >> 2][k & 3], u = acc[3][k >> 2][k & 3]; Ab *= a; Hb = a * Hb + u; }
        float Afq[4], Hfq[4], Abq[4], Hbq[4];
#pragma unroll
        for (int q = 0; q < 4; ++q) { Afq[q] = __shfl(Af, chl + 16 * q); Hfq[q] = __shfl(Hf, chl + 16 * q); Abq[q] = __shfl(Ab, chl + 16 * q); Hbq[q] = __shfl(Hb, chl + 16 * q); }
        const size_t sidx = ((size_t)(b * LRU_NCH + c) * 2) * 1024 + ch;
        if (PASS == 1) {
            float At = 1.f, Ht = 0.f, Bt = 1.f, Gt = 0.f;
#pragma unroll
            for (int q = 0; q < 4; ++q) { At *= Afq[q]; Ht = Afq[q] * Ht + Hfq[q]; }
#pragma unroll
            for (int q = 3; q >= 0; --q) { Bt *= Abq[q]; Gt = Abq[q] * Gt + Hbq[q]; }
            if (qd == 0) { agg[sidx] = (f32x2){At, Ht}; agg[sidx + 1024] = (f32x2){Bt, Gt}; }
        } else {
            float hf = carry[sidx], hb = carry[sidx + 1024];
#pragma unroll
            for (int q = 0; q < 3; ++q) if (q < qd) hf = Afq[q] * hf + Hfq[q];
#pragma unroll
            for (int q = 3; q > 0; --q) if (q > qd) hb = Abq[q] * hb + Hbq[q];
            float yv[16];
#pragma unroll
            for (int k = 0; k < 16; ++k) { hf = acc[0][k >> 2][k & 3] * hf + acc[1][k >> 2][k & 3]; yv[k] = hf; }
#pragma unroll
            for (int k = 15; k >= 0; --k) { hb = acc[2][k >> 2][k & 3] * hb + acc[3][k >> 2][k & 3]; yv[k] += hb; }
#pragma unroll
            for (int k = 0; k < 16; ++k) yb[(qd * 16 + k) * XCF_P + chb] = yv[k];
            __syncthreads();
#pragma unroll
            for (int i = 0; i < 2; ++i) { const int e = tid + 512 * i, t = e >> 4, c8 = e & 15;
                bf16_t* gp = GR + (row0 + t) * 1024 + n * 128 + c8 * 8;
                const u32x4 gv = *(const u32x4*)gp; const f32x4 y0 = *(const LAS f32x4*)(yb + t * XCF_P + c8 * 8), y1 = *(const LAS f32x4*)(yb + t * XCF_P + c8 * 8 + 4);
                const float gg[8] = {bflo(gv.x), bfhi(gv.x), bflo(gv.y), bfhi(gv.y), bflo(gv.z), bfhi(gv.z), bflo(gv.w), bfhi(gv.w)};
                const float yy[8] = {y0.x, y0.y, y0.z, y0.w, y1.x, y1.y, y1.z, y1.w}; float o[8];
#pragma unroll
                for (int j = 0; j < 8; ++j) { const float x = gg[j]; o[j] = yy[j] * x * sigmoidf_(1.5957691216057308f * (x + 0.044715f * x * x * x)); }
                u32x4 w; w.x = pk2(o[0], o[1]); w.y = pk2(o[2], o[3]); w.z = pk2(o[4], o[5]); w.w = pk2(o[6], o[7]);
                *(u32x4*)gp = w; }
        }
    }
    __syncthreads();
}
__device__ __forceinline__ void lru_carry_phase(const f32x2* agg, float* carry, int G) {
    const int lane = threadIdx.x & 63, wave = threadIdx.x >> 6;
    for (int idx = wave * (G * 64) + blockIdx.x * 64 + lane; idx < BATCH * 2 * 1024; idx += G * 512) {
        const int ch = idx & 1023, d = (idx >> 10) & 1, b = idx >> 11; float hcar = 0.f;
        if (d == 0) { for (int c = 0; c < LRU_NCH; ++c) { const size_t s = ((size_t)(b * LRU_NCH + c) * 2) * 1024 + ch; carry[s] = hcar; const f32x2 ah = agg[s]; hcar = ah.x * hcar + ah.y; } }
        else { for (int c = LRU_NCH - 1; c >= 0; --c) { const size_t s = ((size_t)(b * LRU_NCH + c) * 2 + 1) * 1024 + ch; carry[s] = hcar; const f32x2 ah = agg[s]; hcar = ah.x * hcar + ah.y; } }
    }
}

#ifndef PHASE_MASK
#define PHASE_MASK 0xFFFF
#endif
#define PH(k) if ((PHASE_MASK >> (k)) & 1)
__global__ void __launch_bounds__(512, 2) fwd_megakernel(Args args) {
    extern __shared__ __attribute__((aligned(16))) unsigned char lds_raw[];
    LAS unsigned char* lds = (LAS unsigned char*)lds_raw;
    cg::grid_group grid = cg::this_grid();
    const int tid = threadIdx.x, lane = tid & 63, wave = __builtin_amdgcn_readfirstlane(tid >> 6);
    const int G = gridDim.x, wg = blockIdx.x, gw = wg * 8 + wave, NGW = G * 8;
    unsigned char* ws = args.ws;
    const float* x_in = args.in[0]; float* out = args.out;
    bf16_t* WinT = (bf16_t*)(ws + WS_WIN); bf16_t* WoaT = (bf16_t*)(ws + WS_WOA); bf16_t* WolT = (bf16_t*)(ws + WS_WOL); bf16_t* WoutT = (bf16_t*)(ws + WS_WOUT);
    bf16_t* WupT = (bf16_t*)(ws + WS_WUP); bf16_t* WdnT = (bf16_t*)(ws + WS_WDN); bf16_t* WGT = (bf16_t*)(ws + WS_WG);
    float* biasT = (float*)(ws + WS_MISC); float* ss = (float*)(ws + WS_SS); f32x2* agg = (f32x2*)(ws + WS_AGG); float* carry = (float*)(ws + WS_CARRY);
    bf16_t* xb = (bf16_t*)(ws + WS_XB); bf16_t* P = (bf16_t*)(ws + WS_P);

    PH(0) {
        LAS float* scr = (LAS float*)(lds + wave * 16384);
        for (int l = 0; l < DEPTH; ++l) {
            transpose_all(args.in[1] + (size_t)l * D * NIN, D, NIN, WinT + (size_t)l * NIN * D, args.in[14] + l * D, scr, gw, NGW, lane);
            transpose_all(args.in[2] + (size_t)l * D * D, D, D, WoaT + (size_t)l * D * D, nullptr, scr, gw, NGW, lane);
            transpose_all(args.in[3] + (size_t)l * D * D, D, D, WolT + (size_t)l * D * D, nullptr, scr, gw, NGW, lane);
            transpose_all(args.in[4] + (size_t)l * D * D, D, D, WoutT + (size_t)l * D * D, nullptr, scr, gw, NGW, lane);
            transpose_all(args.in[16] + (size_t)l * D * FF, D, FF, WupT + (size_t)l * FF * D, args.in[15] + l * D, scr, gw, NGW, lane);
            transpose_all(args.in[17] + (size_t)l * FF * D, FF, D, WdnT + (size_t)l * D * FF, nullptr, scr, gw, NGW, lane);
        }
        for (int it = gw; it < 2 * 64 * 8; it += NGW) { const int g = it >> 9, mat = (it >> 3) & 63, sub = it & 7;
            transpose_item(args.in[g ? 11 : 9] + (size_t)mat * 16384, 128, 128, WGT + (size_t)((mat >> 3) * 16 + g * 8 + (mat & 7)) * 16384, nullptr, scr, sub, lane); }
        for (int m = gw; m < M; m += NGW) {
            const f32x4* xr = (const f32x4*)(x_in + (size_t)m * D) + lane; f32x4 v[4]; float s = 0.f;
#pragma unroll
            for (int j = 0; j < 4; ++j) { v[j] = xr[64 * j]; s += (v[j].x * v[j].x + v[j].y * v[j].y) + (v[j].z * v[j].z + v[j].w * v[j].w); }
            s = wave_sum(s);
            u32x2* o8 = (u32x2*)(xb + (size_t)m * D) + lane;
#pragma unroll
            for (int j = 0; j < 4; ++j) { u32x2 w; w.x = pk2(v[j].x, v[j].y); w.y = pk2(v[j].z, v[j].w); o8[64 * j] = w; }
            if (lane < 16) ss[(size_t)m * 16 + lane] = lane == 0 ? s : 0.f;
        }
        for (int idx = wg * 512 + tid; idx < 8 * 512; idx += G * 512) { const int hh = idx >> 9, rel = (idx & 511) - 256;
            biasT[idx] = (rel < -128 || rel > 128) ? -1.0e30f : args.in[6][t5_bucket(rel) * 8 + hh] * LOG2E; }
    }
    __syncthreads();
    grid.sync();

#pragma unroll 1
    for (int l = 0; l < DEPTH; ++l) {
        PH(1) { pg8::Gemm g{xb, WinT + (size_t)l * NIN * D, M, NIN, D}; pg8::StaticOrder S; S.init(M, NIN, G, wg); pg8::EpiIn E{P, ss}; pg8::gemm_phase(lds, g, S, E); }
        grid.sync();
        const bf16_t* WGl = WGT + (size_t)l * 32 * 16384;
        PH(2) lru_phase<1>(lds, P + P_XR, P + P_GR, args.in[7] + l * 4096, args.in[8] + l * 1024, WGl, args.in[10] + l * 2048, args.in[12] + l * 2048, args.in[13] + l * 2048, agg, carry, G, wg);
        PH(3) attn_phase(lds, P + P_Q, P + P_KV, biasT, args.in[5] + l * 8, G, wg);
        grid.sync();
        PH(4) lru_carry_phase(agg, carry, G);
        grid.sync();
        PH(5) lru_phase<3>(lds, P + P_XR, P + P_GR, args.in[7] + l * 4096, args.in[8] + l * 1024, WGl, args.in[10] + l * 2048, args.in[12] + l * 2048, args.in[13] + l * 2048, agg, carry, G, wg);
        grid.sync();
        PH(6) { pg8::Gemm g{P + P_Q, WoaT + (size_t)l * D * D, M, D, D}; pg8::StaticOrder S; S.init(M, D, G, wg); pg8::EpiGate<0> E{P + P_GA, P + P_GB}; pg8::gemm_phase(lds, g, S, E); }
        PH(7) { pg8::Gemm g{P + P_GR, WolT + (size_t)l * D * D, M, D, D}; pg8::StaticOrder S; S.init(M, D, G, wg); pg8::EpiGate<1> E{P + P_GA, P + P_GB}; pg8::gemm_phase(lds, g, S, E); }
        grid.sync();
        PH(8) { pg8::Gemm g{P + P_GA, WoutT + (size_t)l * D * D, M, D, D}; pg8::StaticOrder S; S.init(M, D, G, wg); pg8::EpiRes E{l == 0 ? x_in : (const float*)out, out, xb, ss}; pg8::gemm_phase(lds, g, S, E); }
        grid.sync();
        PH(9) { pg8::Gemm g{xb, WupT + (size_t)l * FF * D, M, FF, D}; pg8::StaticOrder S; S.init(M, FF, G, wg); pg8::EpiUp E{P, ss}; pg8::gemm_phase(lds, g, S, E); }
        grid.sync();
        PH(10) { pg8::Gemm g{P, WdnT + (size_t)l * D * FF, M, D, FF}; pg8::StaticOrder S; S.init(M, D, G, wg); pg8::EpiRes E{out, out, xb, ss}; pg8::gemm_phase(lds, g, S, E); }
        grid.sync();
    }
    PH(11) {
        const float* gfin = args.in[18];
        f32x4 gv[4];
#pragma unroll
        for (int j = 0; j < 4; ++j) gv[j] = ((const f32x4*)gfin)[lane + 64 * j];
        for (int m = gw; m < M; m += NGW) {
            f32x4* xr = (f32x4*)(out + (size_t)m * D) + lane; f32x4 v[4]; float s = 0.f;
#pragma unroll
            for (int j = 0; j < 4; ++j) { v[j] = xr[64 * j]; s += (v[j].x * v[j].x + v[j].y * v[j].y) + (v[j].z * v[j].z + v[j].w * v[j].w); }
            s = wave_sum(s);
            const float rs = 1.f / sqrtf(s * (1.f / 1024.f) + 1e-6f);
#pragma unroll
            for (int j = 0; j < 4; ++j) xr[64 * j] = v[j] * rs * gv[j];
        }
    }
}

extern "C" void kernel_launch(void* const* d_in, const int* in_sizes, int n_in, void* d_out, int out_size, void* d_ws, size_t ws_size, hipStream_t stream) {
    static int grid = 0;
    if (grid == 0) {
        if (n_in != 19 || out_size != M * D || ws_size < WS_END) { fprintf(stderr, "kernel_launch: unexpected problem: n_in %d out %d ws %zu (need %zu)\n", n_in, out_size, ws_size, (size_t)WS_END); grid = -1; return; }
        int dev = 0, cus = 0, per_cu = 0;
        hipGetDevice(&dev);
        hipDeviceGetAttribute(&cus, hipDeviceAttributeMultiprocessorCount, dev);
        if (hipFuncSetAttribute((const void*)fwd_megakernel, hipFuncAttributeMaxDynamicSharedMemorySize, LDS_BYTES) != hipSuccess) { fprintf(stderr, "kernel_launch: hipFuncSetAttribute failed\n"); grid = -1; return; }
        if (hipOccupancyMaxActiveBlocksPerMultiprocessor(&per_cu, (const void*)fwd_megakernel, 512, LDS_BYTES) != hipSuccess || per_cu < 1) { fprintf(stderr, "kernel_launch: occupancy query gave %d\n", per_cu); per_cu = 1; }
        (void)hipGetLastError();
        grid = cus * per_cu;
    }
    if (grid < 0) return;
    Args a{};
    for (int i = 0; i < 19; ++i) a.in[i] = (const float*)d_in[i];
    a.out = (float*)d_out; a.ws = (unsigned char*)d_ws;
    void* kargs[] = {&a};
    hipError_t e = hipLaunchCooperativeKernel((const void*)fwd_megakernel, dim3(grid), dim3(512), kargs, LDS_BYTES, stream);
    if (e != hipSuccess) fprintf(stderr, "kernel_launch: cooperative launch failed: %s (grid %d)\n", hipGetErrorString(e), grid);
}
```

```cpp
#include <hip/hip_runtime.h>
#include <hip/hip_cooperative_groups.h>
#include <cstdio>
#include <cstdint>
namespace cg = cooperative_groups;

#define LAS __attribute__((address_space(3)))
typedef unsigned short bf16_t;
typedef short bf16x8 __attribute__((ext_vector_type(8)));
typedef short s16x4 __attribute__((ext_vector_type(4)));
typedef float f32x2 __attribute__((ext_vector_type(2)));
typedef float f32x4 __attribute__((ext_vector_type(4)));
typedef float f32x16 __attribute__((ext_vector_type(16)));
typedef unsigned u32x2 __attribute__((ext_vector_type(2)));
typedef unsigned u32x4 __attribute__((ext_vector_type(4)));
typedef __bf16 bf16x2n __attribute__((ext_vector_type(2)));

constexpr int BATCH = 8, SEQ = 8192, D = 1024, DEPTH = 4, NIN = 5632, FF = 4096;
constexpr int M = BATCH * SEQ;
constexpr float LOG2E = 1.4426950408889634f;
constexpr float QSCALE = 0.08838834764831845f * LOG2E;

constexpr size_t MiB = 1u << 20;
constexpr size_t WS_WIN = 0, WS_WOA = 44 * MiB, WS_WOL = 52 * MiB, WS_WOUT = 60 * MiB, WS_WUP = 68 * MiB, WS_WDN = 100 * MiB, WS_WG = 132 * MiB;
constexpr size_t WS_MISC = 136 * MiB, WS_SS = 137 * MiB, WS_AGG = 141 * MiB, WS_CARRY = 157 * MiB, WS_XB = 165 * MiB, WS_P = 293 * MiB;
constexpr size_t P_Q = 0, P_KV = (size_t)M * 1024, P_XR = P_KV + (size_t)M * 512, P_GR = P_XR + (size_t)M * 1024, P_GA = P_GR + (size_t)M * 1024, P_GB = P_GA + (size_t)M * 1024;
constexpr size_t WS_END = WS_P + (P_GB + (size_t)M * 1024) * 2;
static_assert(WS_END == 997 * MiB, "ws map");
constexpr int LDS_BYTES = 163840;
constexpr int LDS_SS = 131072;
constexpr size_t WS_CTL = WS_MISC + 131072, CTL_BYTES = 65536;

__device__ __forceinline__ unsigned pk2(float a, float b) { f32x2 v = {a, b}; bf16x2n r = __builtin_convertvector(v, bf16x2n); return __builtin_bit_cast(unsigned, r); }
__device__ __forceinline__ float bflo(unsigned u) { return __builtin_bit_cast(float, u << 16); }
__device__ __forceinline__ float bfhi(unsigned u) { return __builtin_bit_cast(float, u & 0xffff0000u); }
__device__ __forceinline__ float sigmoidf_(float x) { return __builtin_amdgcn_rcpf(1.f + __expf(-x)); }

namespace pg8 {
constexpr int BM = 256, BK = 64, HALF = 128, HTB = HALF * BK * 2, STAGE_BYTES = 8 * HTB, NXCD = 8, WGM = 8;
__host__ __device__ __forceinline__ int lds_byte(int r, int c) { const int st = (r >> 4) * 2 + (c >> 5), rr = r & 15, cc = c & 31, ob = rr * 64 + cc * 2; return st * 1024 + (ob ^ (((ob >> 9) & 1) << 5)); }
__host__ __device__ __forceinline__ void stage_rc(int b, int& R, int& C) { const int st = b / 1024, sb = b % 1024, swz = sb ^ (((sb >> 9) & 1) << 5); R = (st >> 1) * 16 + swz / 64; C = (st & 1) * 32 + (swz % 64) / 2; }
__host__ __device__ __forceinline__ int perm32(int rho) { const int n = rho >> 4, i = rho & 15; return 8 * (i >> 2) + 4 * n + (i & 3); }

struct Unit { int pm, pn; };
struct Gemm { const bf16_t* A; const bf16_t* Bt; int M, N, K; };

struct StaticOrder {
    int nM, nN, nwg, G, c;
    __host__ __device__ void init(int M_, int N_, int G_, int c_) { nM = M_ / BM; nN = N_ / BM; nwg = nM * nN; G = G_; c = c_; }
    __host__ __device__ bool next(int i, Unit& u) const {
        const long L = (long)i * G + c; if (L >= nwg) return false;
        int wgid = (int)L; { const int q = nwg / NXCD, r = nwg % NXCD, xcd = wgid % NXCD, off = wgid / NXCD; wgid = (xcd < r ? xcd * (q + 1) : r * (q + 1) + (xcd - r) * q) + off; }
        const int nig = WGM * nN, gid = wgid / nig, fm = gid * WGM, gsz = (nM - fm) < WGM ? (nM - fm) : WGM;
        u.pm = fm + ((wgid % nig) % gsz); u.pn = (wgid % nig) / gsz; return true;
    }
};

__device__ __forceinline__ float row_rstd(const float* ss, int row) {
    const f32x4* p = (const f32x4*)(ss + (size_t)row * 16);
    const f32x4 a = p[0], b = p[1], c = p[2], d = p[3];
    const float s = (((a.x + a.y) + (a.z + a.w)) + ((b.x + b.y) + (b.z + b.w))) + (((c.x + c.y) + (c.z + c.w)) + ((d.x + d.y) + (d.z + d.w)));
    return __builtin_amdgcn_rsqf(s * (1.f / 1024.f) + 1e-6f);
}

__device__ __forceinline__ float row_rstd_lds(const LAS unsigned char* img, int rl) {
    const LAS f32x4* p = (const LAS f32x4*)(img + rl * 64);
    const f32x4 a = p[0], b = p[1], c = p[2], d = p[3];
    const float s = (((a.x + a.y) + (a.z + a.w)) + ((b.x + b.y) + (b.z + b.w))) + (((c.x + c.y) + (c.z + c.w)) + ((d.x + d.y) + (d.z + d.w)));
    return __builtin_amdgcn_rsqf(s * (1.f / 1024.f) + 1e-6f);
}
struct EpiIn {
    static constexpr bool PERM = true, RSTD = true;
    bf16_t* P; const float* ss; int pn_off;
    __device__ __forceinline__ void operator()(const f32x4 (&acc)[2][2][4][2], const Unit& u, int wr, int wc, int fr, int fq, const LAS unsigned char* img) const {
        const int pn = u.pn + pn_off; bf16_t* base; int ld; float sc = 1.f;
        if (pn < 4) { base = P + P_Q + pn * 256; ld = 1024; sc = QSCALE; }
        else if (pn < 6) { base = P + P_KV + (pn - 4) * 256; ld = 512; }
        else { const int t = (pn - 6) >> 2, c = (pn - 6) & 3; base = P + P_XR + (size_t)t * ((size_t)M * 1024) + c * 256; ld = 1024; }
        const bool isgate = (pn >= 10 && pn < 14);
        const int row0 = u.pm * BM + wr * 64 + fr, col0 = wc * 32 + 8 * fq;
#pragma unroll
        for (int ai = 0; ai < 2; ++ai)
#pragma unroll
            for (int m = 0; m < 4; ++m) { const int row = row0 + ai * HALF + m * 16; const float rs = row_rstd_lds(img, wr * 64 + fr + ai * HALF + m * 16) * sc; bf16_t* rowp = base + (size_t)row * ld + col0;
#pragma unroll
                for (int bj = 0; bj < 2; ++bj) { f32x4 v0 = acc[ai][bj][m][0] * rs, v1 = acc[ai][bj][m][1] * rs;
                    if (isgate) {
#pragma unroll
                        for (int j = 0; j < 4; ++j) { const float a = v0[j], b = v1[j];
                            v0[j] = a * __builtin_amdgcn_rcpf(1.f + __builtin_amdgcn_exp2f(-1.5957691216057308f * LOG2E * (a + 0.044715f * a * a * a)));
                            v1[j] = b * __builtin_amdgcn_rcpf(1.f + __builtin_amdgcn_exp2f(-1.5957691216057308f * LOG2E * (b + 0.044715f * b * b * b))); } }
                    u32x4 w; w.x = pk2(v0[0], v0[1]); w.y = pk2(v0[2], v0[3]); w.z = pk2(v1[0], v1[1]); w.w = pk2(v1[2], v1[3]);
                    *(u32x4*)(rowp + bj * HALF) = w; } }
    }
};
struct EpiUp {
    static constexpr bool PERM = true, RSTD = true;
    bf16_t* U; const float* ss;
    __device__ __forceinline__ void operator()(const f32x4 (&acc)[2][2][4][2], const Unit& u, int wr, int wc, int fr, int fq, const LAS unsigned char* img) const {
        const int row0 = u.pm * BM + wr * 64 + fr, col0 = u.pn * BM + wc * 32 + 8 * fq;
#pragma unroll
        for (int ai = 0; ai < 2; ++ai)
#pragma unroll
            for (int m = 0; m < 4; ++m) { const int row = row0 + ai * HALF + m * 16; const float rs = row_rstd_lds(img, wr * 64 + fr + ai * HALF + m * 16); bf16_t* rowp = U + (size_t)row * FF + col0;
#pragma unroll
                for (int bj = 0; bj < 2; ++bj) { f32x4 v0 = acc[ai][bj][m][0] * rs, v1 = acc[ai][bj][m][1] * rs;
#pragma unroll
                    for (int j = 0; j < 4; ++j) { const float a = fmaxf(v0[j], 0.f), b = fmaxf(v1[j], 0.f); v0[j] = a * a; v1[j] = b * b; }
                    u32x4 w; w.x = pk2(v0[0], v0[1]); w.y = pk2(v0[2], v0[3]); w.z = pk2(v1[0], v1[1]); w.w = pk2(v1[2], v1[3]);
                    *(u32x4*)(rowp + bj * HALF) = w; } }
    }
};
template <int STAGE> struct EpiGate {
    static constexpr bool PERM = true, RSTD = false;
    bf16_t* GA; const bf16_t* GB; const float* ss;
    __device__ __forceinline__ void operator()(const f32x4 (&acc)[2][2][4][2], const Unit& u, int wr, int wc, int fr, int fq, const LAS unsigned char* img) const {
        const int row0 = u.pm * BM + wr * 64 + fr, col0 = u.pn * BM + wc * 32 + 8 * fq;
#pragma unroll
        for (int ai = 0; ai < 2; ++ai)
#pragma unroll
            for (int m = 0; m < 4; ++m) { const size_t off = (size_t)(row0 + ai * HALF + m * 16) * 1024 + col0;
#pragma unroll
                for (int bj = 0; bj < 2; ++bj) {
                    const u32x4 g = *(const u32x4*)((STAGE == 0 ? (const bf16_t*)GA : GB) + off + bj * HALF);
                    float s[8] = {bflo(g.x), bfhi(g.x), bflo(g.y), bfhi(g.y), bflo(g.z), bfhi(g.z), bflo(g.w), bfhi(g.w)};
                    float o[8];
#pragma unroll
                    for (int j = 0; j < 8; ++j) o[j] = sigmoidf_(s[j]) * acc[ai][bj][m][j >> 2][j & 3];
                    if (STAGE == 1) { const u32x4 t = *(const u32x4*)(GA + off + bj * HALF);
                        o[0] += bflo(t.x); o[1] += bfhi(t.x); o[2] += bflo(t.y); o[3] += bfhi(t.y); o[4] += bflo(t.z); o[5] += bfhi(t.z); o[6] += bflo(t.w); o[7] += bfhi(t.w); }
                    u32x4 w; w.x = pk2(o[0], o[1]); w.y = pk2(o[2], o[3]); w.z = pk2(o[4], o[5]); w.w = pk2(o[6], o[7]);
                    *(u32x4*)(GA + off + bj * HALF) = w; } }
    }
};
struct EpiRes {
    static constexpr bool PERM = true, RSTD = false;
    bf16_t* xb; float* ss;
    __device__ __forceinline__ void operator()(const f32x4 (&acc)[2][2][4][2], const Unit& u, int wr, int wc, int fr, int fq, const LAS unsigned char* img) const {
        const int row0 = u.pm * BM + wr * 64 + fr, col0 = u.pn * BM + wc * 32 + 8 * fq;
#pragma unroll
        for (int ai = 0; ai < 2; ++ai)
#pragma unroll
            for (int m = 0; m < 4; ++m) { const int row = row0 + ai * HALF + m * 16; const size_t off = (size_t)row * 1024 + col0; float sq = 0.f;
#pragma unroll
                for (int bj = 0; bj < 2; ++bj) { const u32x4 t = *(const u32x4*)(xb + off + bj * HALF);
                    float o[8] = {bflo(t.x), bfhi(t.x), bflo(t.y), bfhi(t.y), bflo(t.z), bfhi(t.z), bflo(t.w), bfhi(t.w)};
#pragma unroll
                    for (int j = 0; j < 8; ++j) { o[j] += acc[ai][bj][m][j >> 2][j & 3]; sq += o[j] * o[j]; }
                    u32x4 w; w.x = pk2(o[0], o[1]); w.y = pk2(o[2], o[3]); w.z = pk2(o[4], o[5]); w.w = pk2(o[6], o[7]);
                    *(u32x4*)(xb + off + bj * HALF) = w; }
                sq += __shfl_xor(sq, 16); sq += __shfl_xor(sq, 32);
                if (fq == 0) ss[(size_t)row * 16 + u.pn * 4 + wc] = sq; }
    }
};

template <class Epi>
__device__ __forceinline__ void gemm_phase(LAS unsigned char* lds, const Gemm g, const StaticOrder& S, const Epi& E) {
    int tid = threadIdx.x; asm volatile("" : "+v"(tid));
    const int wid = __builtin_amdgcn_readfirstlane(tid >> 6), lane = tid & 63, wr = wid >> 2, wc = wid & 3, fr = lane & 15, fq = lane >> 4;
    const int K = g.K, nt = K / BK;
    unsigned voffA[2], voffB[2];
#pragma unroll
    for (int i = 0; i < 2; ++i) { int R, C; stage_rc(tid * 16 + i * 8192, R, C); const int Rb = Epi::PERM ? ((R & ~31) + perm32(R & 31)) : R;
        voffA[i] = (unsigned)(R * K + C) * 2u; voffB[i] = (unsigned)(Rb * K + C) * 2u; }
    const size_t kstep = (size_t)(BK * 2);
    const size_t hstep = (size_t)HALF * K * 2;
    const size_t tstep = 2 * hstep;
    const unsigned ldsw = (unsigned)wid * 1024u;
    const int aoff = lds_byte(wr * 64 + fr, fq * 8), boff = lds_byte(wc * 32 + fr, fq * 8);
#define PG8_SA(b, h) (((b) * 2 + (h)) * HTB)
#define PG8_SB(b, h) ((4 + (b) * 2 + (h)) * HTB)
#define PG8_STAGE(bufoff, gbase, voff) do { _Pragma("unroll") for (int _i = 0; _i < 2; ++_i) \
        __builtin_amdgcn_global_load_lds((const unsigned*)((const char*)(gbase) + (voff)[_i]), (LAS unsigned*)(lds + (bufoff) + ldsw + _i * 8192), 16, 0, 0); } while (0)
#define PG8_LDA(dst, b, h) do { _Pragma("unroll") for (int m = 0; m < 4; ++m) _Pragma("unroll") for (int k = 0; k < 2; ++k) dst[m][k] = *(const LAS bf16x8*)(lds + PG8_SA(b, h) + aoff + m * 2048 + k * 1024); } while (0)
#define PG8_LDB(dst, b, h) do { _Pragma("unroll") for (int n = 0; n < 2; ++n) _Pragma("unroll") for (int k = 0; k < 2; ++k) dst[n][k] = *(const LAS bf16x8*)(lds + PG8_SB(b, h) + boff + n * 2048 + k * 1024); } while (0)
#define PG8_MMA(ai, bj, At, Bt) do { __builtin_amdgcn_s_setprio(1); _Pragma("unroll") for (int m = 0; m < 4; ++m) _Pragma("unroll") for (int n = 0; n < 2; ++n) _Pragma("unroll") for (int k = 0; k < 2; ++k) \
        acc[ai][bj][m][n] = __builtin_amdgcn_mfma_f32_16x16x32_bf16(Bt[n][k], At[m][k], acc[ai][bj][m][n], 0, 0, 0); __builtin_amdgcn_s_setprio(0); } while (0)
#define PG8_WAIT_V(n) asm volatile("s_waitcnt vmcnt(" #n ")" ::: "memory")
#define PG8_WAIT_L(n) asm volatile("s_waitcnt lgkmcnt(" #n ")" ::: "memory")
#define PG8_BAR __builtin_amdgcn_s_barrier()
#define PG8_SCHED __builtin_amdgcn_sched_barrier(0)
    Unit cur, nxt; int ui = 0;
    if (!S.next(0, cur)) return;
    f32x4 acc[2][2][4][2];
#pragma unroll
    for (int a = 0; a < 2; ++a)
#pragma unroll
        for (int b = 0; b < 2; ++b)
#pragma unroll
            for (int m = 0; m < 4; ++m)
#pragma unroll
                for (int n = 0; n < 2; ++n) acc[a][b][m][n] = (f32x4){0.f, 0.f, 0.f, 0.f};
    bf16x8 At[4][2], B0[2][2], B1[2][2];
    const char* cA = (const char*)g.A + (size_t)cur.pm * tstep; const char* cB = (const char*)g.Bt + (size_t)cur.pn * tstep;
    PG8_STAGE(PG8_SB(0, 0), cB, voffB); PG8_STAGE(PG8_SB(0, 1), cB + hstep, voffB); PG8_STAGE(PG8_SA(0, 0), cA, voffA); PG8_STAGE(PG8_SA(0, 1), cA + hstep, voffA);
    if (wr == 1) PG8_BAR;
    PG8_WAIT_V(2); PG8_BAR;
    PG8_STAGE(PG8_SB(1, 0), cB + kstep, voffB); PG8_STAGE(PG8_SA(1, 0), cA + kstep, voffA); PG8_STAGE(PG8_SB(1, 1), cB + hstep + kstep, voffB);
    PG8_WAIT_V(6); PG8_BAR;
    for (;;) {
        const bool has_next = S.next(ui + 1, nxt);
        const char* nA = has_next ? (const char*)g.A + (size_t)nxt.pm * tstep : cA; const char* nB = has_next ? (const char*)g.Bt + (size_t)nxt.pn * tstep : cB;
        LAS unsigned char* img = lds + LDS_SS + (ui & 1) * 16384;
        if constexpr (Epi::RSTD) {
#pragma unroll
            for (int i = 0; i < 2; ++i) __builtin_amdgcn_global_load_lds((const unsigned*)(E.ss + ((size_t)cur.pm * BM) * 16 + (size_t)(tid + 512 * i) * 4), (LAS unsigned*)(img + wid * 1024 + i * 8192), 16, 0, 0);
        }
        for (int t = 0; t < nt; t += 2) {
            const bool last = (t == nt - 2);
            const char* a1 = cA + (size_t)(t + 1) * kstep;
            const char* a2 = last ? nA : cA + (size_t)(t + 2) * kstep; const char* b2 = last ? nB : cB + (size_t)(t + 2) * kstep;
            const char* a3 = a2 + kstep; const char* b3 = b2 + kstep;
            PG8_LDB(B0, 0, 0); PG8_LDB(B1, 0, 1); PG8_SCHED; PG8_LDA(At, 0, 0); PG8_STAGE(PG8_SA(1, 1), a1 + hstep, voffA);
            PG8_WAIT_V(8); PG8_WAIT_L(0); PG8_BAR; PG8_MMA(0, 0, At, B0); PG8_MMA(0, 1, At, B1); PG8_BAR; PG8_SCHED;
            PG8_LDA(At, 0, 1); PG8_STAGE(PG8_SB(0, 0), b2, voffB); PG8_STAGE(PG8_SB(0, 1), b2 + hstep, voffB); PG8_STAGE(PG8_SA(0, 0), a2, voffA);
            PG8_WAIT_V(8); PG8_WAIT_L(0); PG8_BAR; PG8_MMA(1, 0, At, B0); PG8_MMA(1, 1, At, B1); PG8_BAR; PG8_SCHED;
            PG8_LDB(B0, 1, 0); PG8_LDB(B1, 1, 1); PG8_SCHED; PG8_LDA(At, 1, 0); PG8_STAGE(PG8_SA(0, 1), a2 + hstep, voffA);
            PG8_WAIT_V(8); PG8_WAIT_L(0); PG8_BAR; PG8_MMA(0, 0, At, B0); PG8_MMA(0, 1, At, B1); PG8_BAR; PG8_SCHED;
            PG8_LDA(At, 1, 1); PG8_STAGE(PG8_SB(1, 0), b3, voffB); PG8_STAGE(PG8_SB(1, 1), b3 + hstep, voffB); PG8_STAGE(PG8_SA(1, 0), a3, voffA);
            PG8_WAIT_V(8); PG8_WAIT_L(0); PG8_BAR; PG8_MMA(1, 0, At, B0); PG8_MMA(1, 1, At, B1); PG8_BAR; PG8_SCHED;
        }
        if (wr == 0) PG8_BAR;
        E(acc, cur, wr, wc, fr, fq, img);
        if (!has_next) break;
#pragma unroll
        for (int a = 0; a < 2; ++a)
#pragma unroll
            for (int b = 0; b < 2; ++b)
#pragma unroll
                for (int m = 0; m < 4; ++m)
#pragma unroll
                    for (int n = 0; n < 2; ++n) acc[a][b][m][n] = (f32x4){0.f, 0.f, 0.f, 0.f};
        cur = nxt; cA = nA; cB = nB; ++ui;
        if (wr == 1) PG8_BAR;
    }
    PG8_WAIT_V(0);
    PG8_BAR;
#undef PG8_SA
#undef PG8_SB
#undef PG8_STAGE
#undef PG8_LDA
#undef PG8_LDB
#undef PG8_MMA
#undef PG8_WAIT_V
#undef PG8_WAIT_L
#undef PG8_BAR
#undef PG8_SCHED
}
}

struct Args { const float* in[19]; float* out; unsigned char* ws; };

__device__ __forceinline__ float wave_sum(float v) {
#pragma unroll
    for (int o = 1; o < 64; o <<= 1) v += __shfl_xor(v, o);
    return v;
}

__device__ __forceinline__ void transpose_item(const float* W, int K, int N, bf16_t* WT, const float* gain, LAS float* scr, int item, int lane) {
    const int nblk = N / 32, kb = item / nblk, nb = item % nblk, k0 = 64 * kb, n0 = 32 * nb;
    { const int ksub = lane >> 3, n4 = (lane & 7) * 4; f32x4 v[8];
#pragma unroll
      for (int j = 0; j < 8; ++j) v[j] = *(const f32x4*)(W + (size_t)(k0 + 8 * j + ksub) * N + n0 + n4);
#pragma unroll
      for (int j = 0; j < 8; ++j) { const int kk = 8 * j + ksub; const float gsc = gain ? gain[k0 + kk] : 1.f;
          scr[kk * 33 + n4] = v[j].x * gsc; scr[kk * 33 + n4 + 1] = v[j].y * gsc; scr[kk * 33 + n4 + 2] = v[j].z * gsc; scr[kk * 33 + n4 + 3] = v[j].w * gsc; } }
    asm volatile("s_waitcnt lgkmcnt(0)" ::: "memory");
    const int c = lane & 7;
#pragma unroll
    for (int j = 0; j < 4; ++j) { const int n = (lane >> 3) + 8 * j; const LAS float* s = scr + (8 * c) * 33 + n;
        u32x4 o; o.x = pk2(s[0 * 33], s[1 * 33]); o.y = pk2(s[2 * 33], s[3 * 33]); o.z = pk2(s[4 * 33], s[5 * 33]); o.w = pk2(s[6 * 33], s[7 * 33]);
        *(u32x4*)(WT + (size_t)(n0 + n) * K + k0 + 8 * c) = o; }
    asm volatile("s_waitcnt lgkmcnt(0)" ::: "memory");
}
__device__ __forceinline__ void transpose_all(const float* W, int K, int N, bf16_t* WT, const float* gain, LAS float* scr, int gw, int NGW, int lane) {
    const int items = (K / 64) * (N / 32);
    for (int it = gw; it < items; it += NGW) transpose_item(W, K, N, WT, gain, scr, it, lane);
}

__device__ __forceinline__ int t5_bucket(int rel) {
    const int n = rel < 0 ? -rel : rel; int bk;
    if (n < 8) bk = n; else { int j = (31 - __clz(n * n)) - 6; bk = 8 + j; if (bk > 15) bk = 15; }
    return bk + (rel > 0 ? 16 : 0);
}

constexpr int KP = 272;
__device__ __forceinline__ void attn_phase(LAS unsigned char* lds, bf16_t* Q, const bf16_t* KV, const float* biasT, const float* sink, unsigned* queue) {
    int tid = threadIdx.x; asm volatile("" : "+v"(tid));
    const int wave = __builtin_amdgcn_readfirstlane(tid >> 6), lane = tid & 63, r = lane & 31, h = lane >> 5;
    LAS unsigned char* Kb = lds; LAS unsigned char* Vb = lds + 128 * KP; LAS float* bt = (LAS float*)(lds + 2 * 128 * KP);
    const int qt = wave & 3, hl = wave >> 2;
    LAS int* qslot = (LAS int*)(lds + 2 * 128 * KP + 16384);
    LAS unsigned char* ostage = lds + 90112 + wave * (32 * KP);
    __syncthreads();
    for (int e = tid; e < 4096; e += 512) bt[e] = biasT[e];
    if (tid == 0) qslot[0] = (int)__hip_atomic_fetch_add(queue, 1u, __ATOMIC_RELAXED, __HIP_MEMORY_SCOPE_AGENT);
    __syncthreads();
    int item = qslot[0];
    u32x4 kreg[4], vreg[4];
#pragma unroll
    for (int c = 0; c < 4; ++c) { kreg[c] = (u32x4){0u, 0u, 0u, 0u}; vreg[c] = kreg[c]; }
#define ATT_LOAD_AT(b_, kblk_, kvh_) do { const bf16_t* kbase = KV + ((size_t)(b_) * SEQ + (kblk_) * 128) * 512 + (kvh_) * 128; \
        _Pragma("unroll") for (int c = 0; c < 4; ++c) { const int ch = tid + 512 * c, row = ch >> 4, c16 = ch & 15; \
            kreg[c] = *(const u32x4*)(kbase + (size_t)row * 512 + c16 * 8); vreg[c] = *(const u32x4*)(kbase + (size_t)row * 512 + 256 + c16 * 8); } } while (0)
    if (item < BATCH * 64 * 4) { const int qi0 = (item >> 2) & 63; ATT_LOAD_AT(item >> 8, qi0 > 0 ? qi0 - 1 : 0, (item >> 1) & 1); }
    while (item < BATCH * 64 * 4) {
        int nxt = 0, nitem = BATCH * 64 * 4;
        if (tid == 0) nxt = (int)__hip_atomic_fetch_add(queue, 1u, __ATOMIC_RELAXED, __HIP_MEMORY_SCOPE_AGENT);
        const int hp = item & 1, kvh = (item >> 1) & 1, qi = (item >> 2) & 63, b = item >> 8;
        const int head = kvh * 4 + hp * 2 + hl;
        const size_t qrow = (size_t)b * SEQ + qi * 128 + qt * 32 + r;
        bf16x8 qf[8];
#pragma unroll
        for (int ks = 0; ks < 8; ++ks) qf[ks] = *(const bf16x8*)(Q + qrow * 1024 + head * 128 + 16 * ks + 8 * h);
        const float sink2 = sink[head] * LOG2E;
        float mrun = sink2, lrun = 0.f;
        f32x16 O[4];
#pragma unroll
        for (int dt = 0; dt < 4; ++dt)
#pragma unroll
            for (int i = 0; i < 16; ++i) O[dt][i] = 0.f;
        const int kb_lo = qi > 0 ? -1 : 0, kb_hi = qi < 63 ? 1 : 0;
#pragma unroll 1
        for (int kb = kb_lo; kb <= kb_hi; ++kb) {
            if (kb == kb_hi && tid == 0) qslot[1] = nxt;
            __syncthreads();
#pragma unroll
            for (int c = 0; c < 4; ++c) { const int ch = tid + 512 * c, row = ch >> 4, c16 = ch & 15;
                *(LAS u32x4*)(Kb + row * KP + c16 * 16) = kreg[c]; *(LAS u32x4*)(Vb + row * KP + c16 * 16) = vreg[c]; }
            __syncthreads();
            if (kb < kb_hi) ATT_LOAD_AT(b, qi + kb + 1, kvh);
            else { nitem = qslot[1]; if (nitem < BATCH * 64 * 4) { const int qn = (nitem >> 2) & 63; ATT_LOAD_AT(nitem >> 8, qn > 0 ? qn - 1 : 0, (nitem >> 1) & 1); } }
#pragma unroll 1
            for (int sub = 0; sub < 2; ++sub) {
                if (kb == -1 && sub == 0 && qt >= 2) continue;
                if (kb == 1 && sub == 1 && qt <= 1) continue;
                f32x16 sa[2];
#pragma unroll
                for (int i = 0; i < 16; ++i) { sa[0][i] = 0.f; sa[1][i] = 0.f; }
#pragma unroll
                for (int kt = 0; kt < 2; ++kt) {
                    bf16x8 kf[8];
#pragma unroll
                    for (int ks = 0; ks < 8; ++ks) kf[ks] = *(const LAS bf16x8*)(Kb + (64 * sub + 32 * kt + r) * KP + (16 * ks + 8 * h) * 2);
                    __builtin_amdgcn_sched_barrier(0);
#pragma unroll
                    for (int ks = 0; ks < 8; ++ks) sa[kt] = __builtin_amdgcn_mfma_f32_32x32x16_bf16(kf[ks], qf[ks], sa[kt], 0, 0, 0);
                    __builtin_amdgcn_sched_barrier(0);
                }
                const LAS float* btl = bt + head * 512 + (kb * 128 + 64 * sub + 4 * h - 32 * qt - r + 256);
                float mx = -3.0e38f;
#pragma unroll
                for (int kt = 0; kt < 2; ++kt) { float bv[16];
#pragma unroll
                    for (int i = 0; i < 16; ++i) bv[i] = btl[32 * kt + (i & 3) + 8 * (i >> 2)];
#pragma unroll
                    for (int i = 0; i < 16; ++i) { const float sv = sa[kt][i] + bv[i]; sa[kt][i] = sv; mx = fmaxf(mx, sv); } }
                mx = fmaxf(mx, __shfl_xor(mx, 32));
                const float mnew = fmaxf(mrun, mx), alpha = __builtin_amdgcn_exp2f(mrun - mnew);
                const bool grew = mnew > mrun;
                mrun = mnew; lrun *= alpha;
                if (__builtin_amdgcn_ballot_w64(grew) != 0ull) {
#pragma unroll
                    for (int dt = 0; dt < 4; ++dt)
#pragma unroll
                        for (int i = 0; i < 16; ++i) O[dt][i] *= alpha; }
                float ls = 0.f;
#pragma unroll
                for (int kt = 0; kt < 2; ++kt)
#pragma unroll
                    for (int i = 0; i < 16; ++i) { const float p = __builtin_amdgcn_exp2f(sa[kt][i] - mnew); sa[kt][i] = p; ls += p; }
                lrun += ls;
#pragma unroll
                for (int kt = 0; kt < 2; ++kt)
#pragma unroll
                    for (int s2 = 0; s2 < 2; ++s2) {
                        u32x4 pw; pw.x = pk2(sa[kt][8 * s2 + 0], sa[kt][8 * s2 + 1]); pw.y = pk2(sa[kt][8 * s2 + 2], sa[kt][8 * s2 + 3]); pw.z = pk2(sa[kt][8 * s2 + 4], sa[kt][8 * s2 + 5]); pw.w = pk2(sa[kt][8 * s2 + 6], sa[kt][8 * s2 + 7]);
                        const bf16x8 pf = __builtin_bit_cast(bf16x8, pw);
                        const int key0 = 64 * sub + 32 * kt + 16 * s2 + 4 * h + ((lane & 15) >> 2);
                        const LAS unsigned char* vp = Vb + key0 * KP + ((lane >> 4) & 1) * 32 + (lane & 3) * 8;
                        s16x4 lo[4], hi[4];
#pragma unroll
                        for (int dt = 0; dt < 4; ++dt) { lo[dt] = __builtin_amdgcn_ds_read_tr16_b64_v4i16((LAS s16x4*)(vp + dt * 64)); hi[dt] = __builtin_amdgcn_ds_read_tr16_b64_v4i16((LAS s16x4*)(vp + 8 * KP + dt * 64)); }
#pragma unroll
                        for (int dt = 0; dt < 4; ++dt) {
                            const bf16x8 va = __builtin_shufflevector(lo[dt], hi[dt], 0, 1, 2, 3, 4, 5, 6, 7);
                            O[dt] = __builtin_amdgcn_mfma_f32_32x32x16_bf16(va, pf, O[dt], 0, 0, 0); } }
            }
        }
        const float ltot = lrun + __shfl_xor(lrun, 32) + __builtin_amdgcn_exp2f(sink2 - mrun);
        const float inv = 1.f / ltot;
#pragma unroll
        for (int dt = 0; dt < 4; ++dt)
#pragma unroll
            for (int g4 = 0; g4 < 4; ++g4) { u32x2 w; w.x = pk2(O[dt][4 * g4] * inv, O[dt][4 * g4 + 1] * inv); w.y = pk2(O[dt][4 * g4 + 2] * inv, O[dt][4 * g4 + 3] * inv);
                *(LAS u32x2*)(ostage + r * KP + (32 * dt + 8 * g4 + 4 * h) * 2) = w; }
        bf16_t* obase = Q + ((size_t)b * SEQ + qi * 128 + qt * 32) * 1024 + head * 128;
#pragma unroll
        for (int i = 0; i < 8; ++i) { const int c = lane + 64 * i, row = c >> 4, c16 = c & 15;
            const u32x4 w = *(const LAS u32x4*)(ostage + row * KP + c16 * 16);
            *(u32x4*)(obase + (size_t)row * 1024 + c16 * 8) = w; }
        item = nitem;
    }
#undef ATT_LOAD_AT
    __syncthreads();
}

constexpr int LRU_T = 128, LRU_NCH = SEQ / LRU_T, LRU_TASKS = BATCH * 8 * 2;
constexpr int XCF_P = 68, RAW_P = 256;
constexpr int LRU_RAW0 = 0, LRU_RAW1 = LRU_T * RAW_P, LRU_XCF = 2 * LRU_T * RAW_P, LRU_GATE = LRU_XCF + LRU_T * XCF_P * 4, LRU_PF = LRU_GATE + LRU_T * 128, LRU_EX = LRU_PF + LRU_T * 128;
static_assert(LRU_EX + 2 * 64 * 2 * 4 <= LDS_BYTES, "lru lds");
__device__ __forceinline__ float neg_expm1(float x, float a) {
    float p = 1.f + x * 0.2f; p = 1.f + x * 0.25f * p; p = 1.f + x * (1.f / 3.f) * p; p = 1.f + x * 0.5f * p;
    const float small = -x * p, big = __builtin_fmaf(-a, a, 1.f);
    return x < -0.25f ? big : small;
}
constexpr int XC_T = 128;
__device__ __forceinline__ void xc_produce(const bf16_t* XR, bf16_t* XC, const float* conv_w, const float* conv_b, unsigned* flags, unsigned ready, int pw, int NP) {
    int tid = threadIdx.x; asm volatile("" : "+v"(tid));
    const int c8t = tid & 15, trow = tid >> 4;
    const __amdgpu_buffer_rsrc_t xrs = __builtin_amdgcn_make_buffer_rsrc(XC, 0, (int)((size_t)M * 1024 * 2), 0x00020000);
    constexpr int NJ = 64 * (SEQ / XC_T);
    u32x4 xv[2][4][4];
#define XC_LOAD(u, jj) do { const int c_ = (jj) >> 6, p_ = (jj) & 63; const size_t base_ = ((size_t)(p_ >> 3) * SEQ) * 1024 + (size_t)(p_ & 7) * 128 + c8t * 8; \
        _Pragma("unroll") for (int i = 0; i < 4; ++i) _Pragma("unroll") for (int q = 0; q < 4; ++q) { int sq = c_ * XC_T + trow + 32 * i + q - 2; sq = sq < 0 ? 0 : (sq >= SEQ ? SEQ - 1 : sq); \
            xv[u][i][q] = *(const u32x4*)(XR + base_ + (size_t)sq * 1024); } } while (0)
    int pprev = -1; float cwr[5][8];
#pragma unroll
    for (int q = 0; q < 5; ++q)
#pragma unroll
        for (int k = 0; k < 8; ++k) cwr[q][k] = 0.f;
    if (pw < NJ) { XC_LOAD(0, pw); XC_LOAD(1, (pw + NP < NJ ? pw + NP : pw)); }
    for (int j = pw; j < NJ; j += 2 * NP) {
        const bool two = (j + NP < NJ);
#pragma unroll
        for (int u = 0; u < 2; ++u) {
            const int jj = (u && two) ? j + NP : j;
            const int c = jj >> 6, pair = jj & 63, b = pair >> 3, n = pair & 7;
            const size_t col = (size_t)n * 128 + c8t * 8;
            if (pair != pprev) {
#pragma unroll
                for (int q = 0; q < 5; ++q) { const float* src = (q < 4 ? conv_w + q * 1024 : conv_b) + col; const f32x4 w0 = *(const f32x4*)src, w1 = *(const f32x4*)(src + 4);
                    cwr[q][0] = w0.x; cwr[q][1] = w0.y; cwr[q][2] = w0.z; cwr[q][3] = w0.w; cwr[q][4] = w1.x; cwr[q][5] = w1.y; cwr[q][6] = w1.z; cwr[q][7] = w1.w; }
                pprev = pair; }
            if (u == 0 || two) {
#pragma unroll
                for (int i = 0; i < 4; ++i) { const int t = trow + 32 * i;
                    float xc[8];
#pragma unroll
                    for (int k = 0; k < 8; ++k) xc[k] = cwr[4][k];
#pragma unroll
                    for (int q = 0; q < 4; ++q) { const int sq = c * XC_T + t + q - 2; u32x4 v = xv[u][i][q]; if (sq < 0 || sq >= SEQ) v = (u32x4){0u, 0u, 0u, 0u};
                        xc[0] += bflo(v.x) * cwr[q][0]; xc[1] += bfhi(v.x) * cwr[q][1]; xc[2] += bflo(v.y) * cwr[q][2]; xc[3] += bfhi(v.y) * cwr[q][3];
                        xc[4] += bflo(v.z) * cwr[q][4]; xc[5] += bfhi(v.z) * cwr[q][5]; xc[6] += bflo(v.w) * cwr[q][6]; xc[7] += bfhi(v.w) * cwr[q][7]; }
                    u32x4 w; w.x = pk2(xc[0], xc[1]); w.y = pk2(xc[2], xc[3]); w.z = pk2(xc[4], xc[5]); w.w = pk2(xc[6], xc[7]);
                    __builtin_amdgcn_raw_buffer_store_b128(w, xrs, (unsigned)((((size_t)b * SEQ + c * XC_T + t) * 1024 + col) * 2), 0,   16); } }
        }
        if (j + 2 * NP < NJ) { XC_LOAD(0, j + 2 * NP); XC_LOAD(1, (j + 3 * NP < NJ ? j + 3 * NP : j + 2 * NP)); asm volatile("s_waitcnt vmcnt(40)" ::: "memory"); }
        else asm volatile("s_waitcnt vmcnt(8)" ::: "memory");
        __syncthreads();
        if (tid == 0 && j >= pw + 2 * NP) { const int jp = j - 2 * NP;
            __hip_atomic_store(flags + 64 * (jp & 63) + (jp >> 6), ready, __ATOMIC_RELAXED, __HIP_MEMORY_SCOPE_AGENT);
            __hip_atomic_store(flags + 64 * ((jp + NP) & 63) + ((jp + NP) >> 6), ready, __ATOMIC_RELAXED, __HIP_MEMORY_SCOPE_AGENT); }
    }
    asm volatile("s_waitcnt vmcnt(0)" ::: "memory");
    __syncthreads();
    if (tid == 0 && pw < NJ) { int jl = pw; while (jl + 2 * NP < NJ) jl += 2 * NP;
        __hip_atomic_store(flags + 64 * (jl & 63) + (jl >> 6), ready, __ATOMIC_RELAXED, __HIP_MEMORY_SCOPE_AGENT);
        if (jl + NP < NJ) __hip_atomic_store(flags + 64 * ((jl + NP) & 63) + ((jl + NP) >> 6), ready, __ATOMIC_RELAXED, __HIP_MEMORY_SCOPE_AGENT); }
#undef XC_LOAD
}
__device__ __forceinline__ void lru_stream(LAS unsigned char* lds, const bf16_t* XR, bf16_t* GR, bf16_t* T1, bf16_t* XC, const float* conv_w, const float* conv_b, const bf16_t* WG, const float* b_r, const float* b_i,
                                           const float* lam, int task, unsigned* flags, unsigned ready) {
    int tid = threadIdx.x; asm volatile("" : "+v"(tid));
    const int wave = __builtin_amdgcn_readfirstlane(tid >> 6), lane = tid & 63, chl = lane & 15, qd = lane >> 4, cg = wave & 3, th = wave >> 2;
    LAS float* xcf = (LAS float*)(lds + LRU_XCF); LAS unsigned char* gtl = lds + LRU_GATE; LAS unsigned char* pfl = lds + LRU_PF; LAS float* ex = (LAS float*)(lds + LRU_EX);
    const int b = task >> 4, n = (task >> 1) & 7, h2 = task & 1;
    const int chh = cg * 16 + chl, chb = h2 * 64 + chh, ch = n * 128 + chb;
    const int c8t = tid & 15; const bool own = (c8t >> 3) == h2;
    const size_t colg = (size_t)n * 128 + h2 * 64;
    __syncthreads();
#define LRU_LOAD_XC(cc) do { _Pragma("unroll") for (int i = 0; i < 4; ++i) { const int e = tid + 512 * i, rr = e >> 4, key = ((rr >> 4) & 3) * 4 + (rr & 3); \
            __builtin_amdgcn_global_load_lds((const unsigned*)(XC + ((size_t)b * SEQ + (cc) * LRU_T + rr) * 1024 + n * 128 + ((e & 15) ^ key) * 8), (LAS unsigned*)(lds + ((cc) & 1) * (LRU_T * RAW_P) + wave * 1024 + i * 8192), 16, 0, 0); } } while (0)
#define LRU_LOAD_TILE(src, dstl, cc) do { _Pragma("unroll") for (int i = 0; i < 2; ++i) { const int e = tid + 512 * i; \
            __builtin_amdgcn_global_load_lds((const unsigned*)((src) + ((size_t)b * SEQ + (cc) * LRU_T + (e >> 3)) * 1024 + colg + (e & 7) * 8), (LAS unsigned*)((dstl) + wave * 1024 + i * 8192), 16, 0, 0); } } while (0)
#pragma unroll
    for (int dir = 0; dir < 2; ++dir) {
        bf16x8 bw[2][4];
#pragma unroll
        for (int gi = 0; gi < 2; ++gi)
#pragma unroll
            for (int ks = 0; ks < 4; ++ks) bw[gi][ks] = *(const bf16x8*)(WG + ((size_t)((dir * 2 + gi) * 8 + n) * 128 + chb) * 128 + 32 * ks + 8 * qd);
        const float nbr = -LOG2E * b_r[dir * 1024 + ch], nbi = -LOG2E * b_i[dir * 1024 + ch], cl2 = -8.f * LOG2E * log1pf(expf(-lam[dir * 1024 + ch]));
        float hcar = 0.f;
        unsigned* fl = flags + 64 * (task >> 1);
        if (!dir && tid == 0) {
            for (int k = 0; k < 8; ++k) while (__hip_atomic_load(fl + k, __ATOMIC_RELAXED, __HIP_MEMORY_SCOPE_AGENT) < ready) __builtin_amdgcn_s_sleep(2);
            __builtin_amdgcn_fence(__ATOMIC_ACQUIRE, "agent"); asm volatile("s_waitcnt vmcnt(0)" ::: "memory"); }
        __syncthreads();
        LRU_LOAD_XC(dir ? LRU_NCH - 1 : 0);
        u32x4 gcur[2], pcur[2], gnxt[2], pnxt[2];
#pragma unroll
        for (int i = 0; i < 2; ++i) { gcur[i] = (u32x4){0u, 0u, 0u, 0u}; pcur[i] = gcur[i]; gnxt[i] = gcur[i]; pnxt[i] = gcur[i]; }
#define LRU_LOAD_GP(gd, pd, cc) do { _Pragma("unroll") for (int i = 0; i < 2; ++i) { const int e = tid + 512 * i; const size_t o_ = ((size_t)b * SEQ + (cc) * LRU_T + (e >> 3)) * 1024 + colg + (e & 7) * 8; \
            gd[i] = *(const u32x4*)(GR + o_); pd[i] = *(const u32x4*)(T1 + o_); } } while (0)
        if (dir) LRU_LOAD_GP(gcur, pcur, LRU_NCH - 1);
#pragma unroll 1
        for (int it = 0; it < LRU_NCH; ++it) {
            const int c = dir ? LRU_NCH - 1 - it : it;
            const size_t row0 = (size_t)b * SEQ + c * LRU_T;
            if (!dir && ((c + 1) & 7) == 0 && it + 1 < LRU_NCH && tid == 0) {
                for (int k = 1; k <= 8; ++k) while (__hip_atomic_load(fl + c + k, __ATOMIC_RELAXED, __HIP_MEMORY_SCOPE_AGENT) < ready) __builtin_amdgcn_s_sleep(2);
                __builtin_amdgcn_fence(__ATOMIC_ACQUIRE, "agent"); asm volatile("s_waitcnt vmcnt(0)" ::: "memory"); }
            if (it == 0) asm volatile("s_waitcnt vmcnt(0)" ::: "memory"); else if (dir) asm volatile("s_waitcnt vmcnt(6)" ::: "memory"); else asm volatile("s_waitcnt vmcnt(2)" ::: "memory");
            __syncthreads();
            if (it + 1 < LRU_NCH) LRU_LOAD_XC(dir ? c - 1 : c + 1);
            if (dir && it + 1 < LRU_NCH) LRU_LOAD_GP(gnxt, pnxt, c - 1);
            const LAS unsigned char* img = lds + (c & 1) * (LRU_T * RAW_P);
            f32x4 acc[2][4];
#pragma unroll
            for (int gi = 0; gi < 2; ++gi)
#pragma unroll
                for (int mt = 0; mt < 4; ++mt) acc[gi][mt] = (f32x4){0.f, 0.f, 0.f, 0.f};
#pragma unroll
            for (int ks = 0; ks < 4; ++ks) {
                bf16x8 af[4];
#pragma unroll
                for (int mt = 0; mt < 4; ++mt) { const int tok = th * 64 + (chl >> 2) * 16 + 4 * mt + (chl & 3); af[mt] = *(const LAS bf16x8*)(img + tok * RAW_P + (((4 * ks + qd) ^ chl) << 4)); }
#pragma unroll
                for (int gi = 0; gi < 2; ++gi)
#pragma unroll
                    for (int mt = 0; mt < 4; ++mt) acc[gi][mt] = __builtin_amdgcn_mfma_f32_16x16x32_bf16(af[mt], bw[gi][ks], acc[gi][mt], 0, 0, 0);
            }
#pragma unroll
            for (int mt = 0; mt < 4; ++mt)
#pragma unroll
                for (int j = 0; j < 4; ++j) { const float x = __builtin_bit_cast(float, (unsigned)*(const LAS unsigned short*)(img + (th * 64 + qd * 16 + 4 * mt + j) * RAW_P + ((((chb >> 3) ^ (4 * qd)) ^ j) << 4) + (chb & 7) * 2) << 16);
                    const float e1 = __builtin_amdgcn_exp2f(__builtin_fmaf(acc[0][mt][j], -LOG2E, nbr)), e2 = __builtin_amdgcn_exp2f(__builtin_fmaf(acc[1][mt][j], -LOG2E, nbi));
                    const float rg = __builtin_amdgcn_rcpf(1.f + e1), ig = __builtin_amdgcn_rcpf(1.f + e2);
                    const float a = __builtin_amdgcn_exp2f(rg * cl2), mult = __builtin_amdgcn_sqrtf(__builtin_fmaf(-a, a, 1.f));
                    acc[0][mt][j] = a; acc[1][mt][j] = mult * ig * x; }
            float As = 1.f, Hs = 0.f;
#pragma unroll
            for (int kk = 0; kk < 16; ++kk) { const int k = dir ? 15 - kk : kk; const float a = acc[0][k >> 2][k & 3], u = acc[1][k >> 2][k & 3]; As *= a; Hs = a * Hs + u; }
            float Aq[4], Hq[4];
#pragma unroll
            for (int q = 0; q < 4; ++q) { Aq[q] = __shfl(As, chl + 16 * q); Hq[q] = __shfl(Hs, chl + 16 * q); }
            float Aw = 1.f, Hw = 0.f;
#pragma unroll
            for (int qq = 0; qq < 4; ++qq) { const int q = dir ? 3 - qq : qq; Aw *= Aq[q]; Hw = Aq[q] * Hw + Hq[q]; }
            if (qd == 0) { ex[(th * 64 + chh) * 2] = Aw; ex[(th * 64 + chh) * 2 + 1] = Hw; }
            __syncthreads();
            const float Ao = ex[((1 - th) * 64 + chh) * 2], Ho = ex[((1 - th) * 64 + chh) * 2 + 1];
            const bool first = (th == dir);
            const float A1 = first ? Aw : Ao, H1 = first ? Hw : Ho, A2 = first ? Ao : Aw, H2 = first ? Ho : Hw;
            const float hmid = A1 * hcar + H1;
            float h = first ? hcar : hmid;
            hcar = A2 * hmid + H2;
#pragma unroll
            for (int qq = 0; qq < 3; ++qq) { const int q = dir ? 3 - qq : qq; if (dir ? (q > qd) : (q < qd)) h = Aq[q] * h + Hq[q]; }
#pragma unroll
            for (int kk = 0; kk < 16; ++kk) { const int k = dir ? 15 - kk : kk; h = acc[0][k >> 2][k & 3] * h + acc[1][k >> 2][k & 3]; xcf[(th * 64 + qd * 16 + k) * XCF_P + chh] = h; }
            __syncthreads();
#pragma unroll
            for (int i = 0; i < 2; ++i) { const int e = tid + 512 * i, t = e >> 3, c8 = e & 7;
                const u32x4 gv = gcur[i]; const f32x4 y0 = *(const LAS f32x4*)(xcf + t * XCF_P + c8 * 8), y1 = *(const LAS f32x4*)(xcf + t * XCF_P + c8 * 8 + 4);
                float o[8] = {y0.x, y0.y, y0.z, y0.w, y1.x, y1.y, y1.z, y1.w};
                if (dir) { const u32x4 pv = pcur[i];
                    o[0] += bflo(pv.x); o[1] += bfhi(pv.x); o[2] += bflo(pv.y); o[3] += bfhi(pv.y); o[4] += bflo(pv.z); o[5] += bfhi(pv.z); o[6] += bflo(pv.w); o[7] += bfhi(pv.w);
                    const float gg[8] = {bflo(gv.x), bfhi(gv.x), bflo(gv.y), bfhi(gv.y), bflo(gv.z), bfhi(gv.z), bflo(gv.w), bfhi(gv.w)};
#pragma unroll
                    for (int j = 0; j < 8; ++j) o[j] *= gg[j]; }
                u32x4 w; w.x = pk2(o[0], o[1]); w.y = pk2(o[2], o[3]); w.z = pk2(o[4], o[5]); w.w = pk2(o[6], o[7]);
                *(u32x4*)((dir ? GR : T1) + (row0 + t) * 1024 + colg + c8 * 8) = w; }
            if (dir) {
#pragma unroll
                for (int i = 0; i < 2; ++i) { gcur[i] = gnxt[i]; pcur[i] = pnxt[i]; } }
        }
    }
#undef LRU_LOAD_XC
#undef LRU_LOAD_TILE
#undef LRU_LOAD_GP
    asm volatile("s_waitcnt vmcnt(0)" ::: "memory");
    __syncthreads();
}
#define XB_TMO      128
#define XB_XCNT(j)  (256  + 64 * (j))
#define XB_XSUB(j)  (1280 + 64 * (j))
#define XB_XGEN(j)  (2304 + 64 * (j))
#define XB_TOP      3328
#define XB_TOPGEN   3392
#define XCD_BAR_WORDS 3456
#define XB_SPIN_CAP (1u << 22)
__device__ __forceinline__ unsigned xb_ld(unsigned* p)              { return __hip_atomic_load(p, __ATOMIC_RELAXED, __HIP_MEMORY_SCOPE_AGENT); }
__device__ __forceinline__ unsigned xb_add(unsigned* p, unsigned v) { return __hip_atomic_fetch_add(p, v, __ATOMIC_RELAXED, __HIP_MEMORY_SCOPE_AGENT); }
__device__ __forceinline__ unsigned xb_xcc_id() { return (unsigned)__builtin_amdgcn_s_getreg((3 << 11) | 20) & 0xFu; }
#define XB_SPIN(cond, bar) do { unsigned _sp = 0; while (cond) { __builtin_amdgcn_s_sleep(1); \
    if ((++_sp & 255u) == 0u) { if (xb_ld(&(bar)[XB_TMO])) break; if (_sp > XB_SPIN_CAP) { atomicAdd(&(bar)[XB_TMO], 1u); break; } } } } while (0)
struct XcdBarrier { unsigned* bar; unsigned x; };
__device__ __forceinline__ XcdBarrier xcd_barrier_post(unsigned* bar) {
    XcdBarrier b; b.bar = bar; b.x = xb_xcc_id();
    if (threadIdx.x == 0) (void)xb_add(&bar[XB_XCNT(b.x)], 1u);
    return b;
}
__device__ __forceinline__ void xcd_barrier_complete(unsigned* bar, unsigned x, unsigned& nloc, unsigned& nx) {
    const unsigned G = gridDim.x * gridDim.y * gridDim.z;
    unsigned sum, cnt, mine, sp = 0u;
    for (;;) {
        sum = 0u; cnt = 0u; mine = 0u;
#pragma unroll
        for (unsigned j = 0; j < 16; ++j) { const unsigned c = xb_ld(&bar[XB_XCNT(j)]); sum += c; cnt += (c > 0u) ? 1u : 0u; mine = (j == x) ? c : mine; }
        if (sum == G) break;
        __builtin_amdgcn_s_sleep(1);
        if ((++sp & 255u) == 0u) { if (xb_ld(&bar[XB_TMO])) break; if (sp > XB_SPIN_CAP) { atomicAdd(&bar[XB_TMO], 1u); break; } }
    }
    nloc = mine > 0u ? mine : 1u; nx = cnt > 0u ? cnt : 1u;
}
__device__ __forceinline__ void xcd_barrier(const XcdBarrier& b, unsigned& nloc_s, unsigned& nx_s) {
    asm volatile("s_waitcnt vmcnt(0)" ::: "memory");
    __syncthreads();
    if (threadIdx.x == 0) {
        unsigned* bar = b.bar;
        __builtin_amdgcn_s_waitcnt(0);
        unsigned nloc = nloc_s, nx = nx_s;
        if (nloc == 0u) { xcd_barrier_complete(bar, b.x, nloc, nx); nloc_s = nloc; nx_s = nx; }
        const unsigned old = xb_add(&bar[XB_XSUB(b.x)], 1u);
        const unsigned gen = old / nloc;
        if (old + 1u == (gen + 1u) * nloc) {
            __builtin_amdgcn_fence(__ATOMIC_RELEASE, "agent");
            asm volatile("s_waitcnt vmcnt(0)" ::: "memory");
            const unsigned og = xb_add(&bar[XB_TOP], 1u);
            const unsigned tg = og / nx;
            if (og + 1u == (tg + 1u) * nx) xb_add(&bar[XB_TOPGEN], 1u);
            else XB_SPIN(xb_ld(&bar[XB_TOPGEN]) == tg, bar);
            __builtin_amdgcn_fence(__ATOMIC_ACQUIRE, "agent");
            xb_add(&bar[XB_XGEN(b.x)], 1u);
            asm volatile("s_waitcnt vmcnt(0)" ::: "memory");
        } else {
            XB_SPIN(xb_ld(&bar[XB_XGEN(b.x)]) == gen, bar);
            __builtin_amdgcn_fence(__ATOMIC_ACQUIRE, "agent");
            asm volatile("s_waitcnt vmcnt(0)" ::: "memory");
        }
    }
    __syncthreads();
}

__device__ __forceinline__ void sub_barrier(unsigned* ctr, unsigned target) {
    asm volatile("s_waitcnt vmcnt(0)" ::: "memory");
    __syncthreads();
    if (threadIdx.x == 0) {
        __builtin_amdgcn_s_waitcnt(0);
        __builtin_amdgcn_fence(__ATOMIC_RELEASE, "agent");
        asm volatile("s_waitcnt vmcnt(0)" ::: "memory");
        (void)xb_add(ctr, 1u);
        unsigned sp = 0;
        while (xb_ld(ctr) < target) { __builtin_amdgcn_s_sleep(2); if (++sp > (1u << 24)) break; }
        __builtin_amdgcn_fence(__ATOMIC_ACQUIRE, "agent");
        asm volatile("s_waitcnt vmcnt(0)" ::: "memory");
    }
    __syncthreads();
}

#ifndef PHASE_MASK
#define PHASE_MASK 0xFFFF
#endif
#define PH(k) if ((PHASE_MASK >> (k)) & 1)
__global__ void __launch_bounds__(512, 2) fwd_megakernel(Args args) {
    extern __shared__ __attribute__((aligned(16))) unsigned char lds_raw[];
    LAS unsigned char* lds = (LAS unsigned char*)lds_raw;
    cg::grid_group grid = cg::this_grid();
    const int tid = threadIdx.x, lane = tid & 63, wave = __builtin_amdgcn_readfirstlane(tid >> 6);
    const int G = gridDim.x, wg = blockIdx.x, gw = wg * 8 + wave, NGW = G * 8;
    unsigned char* ws = args.ws;
    const XcdBarrier xbar = xcd_barrier_post((unsigned*)(ws + WS_CTL)); unsigned xb_nloc = 0u, xb_nx = 0u;
    const float* x_in = args.in[0]; float* out = args.out;
    bf16_t* WinT = (bf16_t*)(ws + WS_WIN); bf16_t* WoaT = (bf16_t*)(ws + WS_WOA); bf16_t* WolT = (bf16_t*)(ws + WS_WOL); bf16_t* WoutT = (bf16_t*)(ws + WS_WOUT);
    bf16_t* WupT = (bf16_t*)(ws + WS_WUP); bf16_t* WdnT = (bf16_t*)(ws + WS_WDN); bf16_t* WGT = (bf16_t*)(ws + WS_WG);
    float* biasT = (float*)(ws + WS_MISC); float* ss = (float*)(ws + WS_SS); unsigned* queue = (unsigned*)(ws + WS_CTL + 32768); unsigned* xcflags = (unsigned*)(ws + WS_CTL + 40960);
    bf16_t* xb = (bf16_t*)(ws + WS_XB); bf16_t* P = (bf16_t*)(ws + WS_P);

#ifdef PROBE_A
    unsigned long long tprev = __builtin_amdgcn_s_memrealtime(); float pa = 0.f, pb = 0.f;
#define STAMP(k) do { const unsigned long long tn = __builtin_amdgcn_s_memrealtime(); const float dt = (float)(tn - tprev) * 0.01f; tprev = tn; if ((PROBE_A >> (k)) & 1) pa += dt; if ((PROBE_B >> (k)) & 1) pb += dt; } while (0)
#else
#define STAMP(k) do {} while (0)
#endif
    PH(0) {
        LAS float* scr = (LAS float*)(lds + wave * 16384);
#define CONVERT_LAYER(lw, gwv, ngwv) do { const int l_ = (lw); \
            constexpr int I_IN = (D / 64) * (NIN / 32), I_DD = (D / 64) * (D / 32), I_UP = (D / 64) * (FF / 32), I_DN = (FF / 64) * (D / 32), I_G = 2 * 16 * 8; \
            _Pragma("unroll 1") for (int it = (gwv); it < I_IN + 3 * I_DD + I_UP + I_DN + I_G; it += (ngwv)) { \
                int r_ = it; const float* W_; bf16_t* WT_; const float* gn_ = nullptr; int K_ = D, N_ = D; \
                if (r_ < I_IN) { W_ = args.in[1] + (size_t)l_ * D * NIN; WT_ = WinT + (size_t)l_ * NIN * D; gn_ = args.in[14] + l_ * D; N_ = NIN; } \
                else if ((r_ -= I_IN) < 3 * I_DD) { const int m_ = r_ / I_DD; r_ -= m_ * I_DD; W_ = args.in[2 + m_] + (size_t)l_ * D * D; WT_ = (m_ == 0 ? WoaT : (m_ == 1 ? WolT : WoutT)) + (size_t)l_ * D * D; } \
                else if ((r_ -= 3 * I_DD) < I_UP) { W_ = args.in[16] + (size_t)l_ * D * FF; WT_ = WupT + (size_t)l_ * FF * D; gn_ = args.in[15] + l_ * D; N_ = FF; } \
                else if ((r_ -= I_UP) < I_DN) { W_ = args.in[17] + (size_t)l_ * FF * D; WT_ = WdnT + (size_t)l_ * D * FF; K_ = FF; } \
                else { r_ -= I_DN; const int g_ = r_ >> 7, mat_ = l_ * 16 + ((r_ >> 3) & 15); r_ &= 7; K_ = 128; N_ = 128; \
                    W_ = args.in[g_ ? 11 : 9] + (size_t)mat_ * 16384; WT_ = WGT + (size_t)((mat_ >> 3) * 16 + g_ * 8 + (mat_ & 7)) * 16384; } \
                transpose_item(W_, K_, N_, WT_, gn_, scr, r_, lane); } } while (0)
        CONVERT_LAYER(0, gw, NGW);
        for (int m0 = 2 * gw; m0 < M; m0 += 2 * NGW) {
            f32x4 v[2][4]; float sq[2];
#pragma unroll
            for (int r2 = 0; r2 < 2; ++r2) { const f32x4* xr = (const f32x4*)(x_in + (size_t)(m0 + r2) * D) + lane;
#pragma unroll
                for (int j = 0; j < 4; ++j) v[r2][j] = xr[64 * j]; }
#pragma unroll
            for (int r2 = 0; r2 < 2; ++r2) { float s = 0.f;
#pragma unroll
                for (int j = 0; j < 4; ++j) s += (v[r2][j].x * v[r2][j].x + v[r2][j].y * v[r2][j].y) + (v[r2][j].z * v[r2][j].z + v[r2][j].w * v[r2][j].w);
                sq[r2] = wave_sum(s);
                u32x2* o8 = (u32x2*)(xb + (size_t)(m0 + r2) * D) + lane;
#pragma unroll
                for (int j = 0; j < 4; ++j) { u32x2 w; w.x = pk2(v[r2][j].x, v[r2][j].y); w.y = pk2(v[r2][j].z, v[r2][j].w); o8[64 * j] = w; }
                if (lane < 16) ss[(size_t)(m0 + r2) * 16 + lane] = lane == 0 ? sq[r2] : 0.f; }
        }
        if (wg == 0 && tid < DEPTH) queue[tid * 64] = 0u;
        for (int idx = wg * 512 + tid; idx < 8 * 512; idx += G * 512) { const int hh = idx >> 9, rel = (idx & 511) - 256;
            biasT[idx] = (rel < -128 || rel > 128) ? -1.0e30f : args.in[6][t5_bucket(rel) * 8 + hh] * LOG2E; }
    }
    __syncthreads();
    grid.sync(); STAMP(0);

#pragma unroll 1
    for (int l = 0; l < DEPTH; ++l) {
        PH(1) { pg8::Gemm g{xb, WinT + (size_t)l * NIN * D, M, NIN, D}; pg8::StaticOrder S; S.init(M, NIN, G, wg); pg8::EpiIn E{P, ss, 0}; pg8::gemm_phase(lds, g, S, E); }
        xcd_barrier(xbar, xb_nloc, xb_nx); STAMP(1);
        const bf16_t* WGl = WGT + (size_t)l * 32 * 16384;
        const int GH = G >> 1;
        if (wg < GH) {
            PH(2) { for (int task = wg; task < LRU_TASKS; task += GH) lru_stream(lds, P + P_XR, P + P_GR, (bf16_t*)out, (bf16_t*)out + (size_t)M * 1024, args.in[7] + l * 4096, args.in[8] + l * 1024, WGl, args.in[10] + l * 2048, args.in[12] + l * 2048, args.in[13] + l * 2048, task, xcflags, (unsigned)(l + 1)); }
        } else {
            PH(2) xc_produce(P + P_XR, (bf16_t*)out + (size_t)M * 1024, args.in[7] + l * 4096, args.in[8] + l * 1024, xcflags, (unsigned)(l + 1), wg - GH, G - GH);
            PH(3) attn_phase(lds, P + P_Q, P + P_KV, biasT, args.in[5] + l * 8, queue + l * 64);
            PH(0) if (l + 1 < DEPTH) { int tidc = threadIdx.x; asm volatile("" : "+v"(tidc)); const int lane = tidc & 63, wv = __builtin_amdgcn_readfirstlane(tidc >> 6); LAS float* scr = (LAS float*)(lds + wv * 16384);
                CONVERT_LAYER(l + 1, (wg - GH) * 8 + wv, (G - GH) * 8); }
        }
        STAMP(2);
        xcd_barrier(xbar, xb_nloc, xb_nx); STAMP(3);
        PH(6) { pg8::Gemm g{P + P_Q, WoaT + (size_t)l * D * D, M, D, D}; pg8::StaticOrder S; S.init(M, D, G, wg); pg8::EpiGate<0> E{P + P_GA, P + P_GB, nullptr}; pg8::gemm_phase(lds, g, S, E); }
        STAMP(6);
        PH(7) { pg8::Gemm g{P + P_GR, WolT + (size_t)l * D * D, M, D, D}; pg8::StaticOrder S; S.init(M, D, G, wg); pg8::EpiGate<1> E{P + P_GA, P + P_GB, nullptr}; pg8::gemm_phase(lds, g, S, E); }
        xcd_barrier(xbar, xb_nloc, xb_nx); STAMP(7);
        PH(8) { pg8::Gemm g{P + P_GA, WoutT + (size_t)l * D * D, M, D, D}; pg8::StaticOrder S; S.init(M, D, G, wg); pg8::EpiRes E{xb, ss}; pg8::gemm_phase(lds, g, S, E); }
        xcd_barrier(xbar, xb_nloc, xb_nx); STAMP(8);
        PH(9) { pg8::Gemm g{xb, WupT + (size_t)l * FF * D, M, FF, D}; pg8::StaticOrder S; S.init(M, FF, G, wg); pg8::EpiUp E{P, ss}; pg8::gemm_phase(lds, g, S, E); }
        xcd_barrier(xbar, xb_nloc, xb_nx); STAMP(9);
        PH(10) { pg8::Gemm g{P, WdnT + (size_t)l * D * FF, M, D, FF}; pg8::StaticOrder S; S.init(M, D, G, wg); pg8::EpiRes E{xb, ss}; pg8::gemm_phase(lds, g, S, E); }
        xcd_barrier(xbar, xb_nloc, xb_nx); STAMP(10);
    }
#ifdef PROBE_A
    if (wg == 0 && tid == 0) { biasT[8192] = exp2f(rintf(log2f(pa) * 3.f) * (1.f / 3.f)); biasT[8193] = exp2f(rintf(log2f(pb) * 3.f) * (1.f / 3.f)) * 0.001f; }
    __threadfence(); xcd_barrier(xbar, xb_nloc, xb_nx);
    const float probeA = biasT[8192], probeB = biasT[8193];
#endif
    PH(11) {
        int tidf = threadIdx.x; asm volatile("" : "+v"(tidf));
        const int lane = tidf & 63, gw = wg * 8 + __builtin_amdgcn_readfirstlane(tidf >> 6);
        const float* gfin = args.in[18];
        f32x4 gv[4];
#pragma unroll
        for (int j = 0; j < 4; ++j) gv[j] = ((const f32x4*)gfin)[lane + 64 * j];
        for (int m0 = 2 * gw; m0 < M; m0 += 2 * NGW) {
            u32x2 t[2][4];
#pragma unroll
            for (int r2 = 0; r2 < 2; ++r2) { const u32x2* xi = (const u32x2*)(xb + (size_t)(m0 + r2) * D) + lane;
#pragma unroll
                for (int j = 0; j < 4; ++j) t[r2][j] = xi[64 * j]; }
#pragma unroll
            for (int r2 = 0; r2 < 2; ++r2) { f32x4 v[4]; float s = 0.f;
#pragma unroll
                for (int j = 0; j < 4; ++j) { v[j] = (f32x4){bflo(t[r2][j].x), bfhi(t[r2][j].x), bflo(t[r2][j].y), bfhi(t[r2][j].y)}; s += (v[j].x * v[j].x + v[j].y * v[j].y) + (v[j].z * v[j].z + v[j].w * v[j].w); }
                s = wave_sum(s);
                const float rs = 1.f / sqrtf(s * (1.f / 1024.f) + 1e-6f);
                f32x4* xr = (f32x4*)(out + (size_t)(m0 + r2) * D) + lane;
#pragma unroll
                for (int j = 0; j < 4; ++j) {
#ifdef PROBE_A
                    f32x4 o = v[j] * rs * gv[j] + probeB; if (m0 + r2 == 0 && lane == 0 && j == 0) o.x += probeA; xr[64 * j] = o;
#else
                    xr[64 * j] = v[j] * rs * gv[j];
#endif
                } }
        }
    }
}

extern "C" void kernel_launch(void* const* d_in, const int* in_sizes, int n_in, void* d_out, int out_size, void* d_ws, size_t ws_size, hipStream_t stream) {
    static int grid = 0;
    if (grid == 0) {
        if (n_in != 19 || out_size != M * D || ws_size < WS_END) { fprintf(stderr, "kernel_launch: unexpected problem: n_in %d out %d ws %zu (need %zu)\n", n_in, out_size, ws_size, (size_t)WS_END); grid = -1; return; }
        int dev = 0, cus = 0, per_cu = 0;
        hipGetDevice(&dev);
        hipDeviceGetAttribute(&cus, hipDeviceAttributeMultiprocessorCount, dev);
        if (hipFuncSetAttribute((const void*)fwd_megakernel, hipFuncAttributeMaxDynamicSharedMemorySize, LDS_BYTES) != hipSuccess) { fprintf(stderr, "kernel_launch: hipFuncSetAttribute failed\n"); grid = -1; return; }
        if (hipOccupancyMaxActiveBlocksPerMultiprocessor(&per_cu, (const void*)fwd_megakernel, 512, LDS_BYTES) != hipSuccess || per_cu < 1) { fprintf(stderr, "kernel_launch: occupancy query gave %d\n", per_cu); per_cu = 1; }
        (void)hipGetLastError();
        grid = cus * per_cu;
    }
    if (grid < 0) return;
    if (hipMemsetAsync((char*)d_ws + WS_CTL, 0, CTL_BYTES, stream) != hipSuccess) { fprintf(stderr, "kernel_launch: memset failed\n"); return; }
    Args a{};
    for (int i = 0; i < 19; ++i) a.in[i] = (const float*)d_in[i];
    a.out = (float*)d_out; a.ws = (unsigned char*)d_ws;
    void* kargs[] = {&a};
    hipError_t e = hipLaunchCooperativeKernel((const void*)fwd_megakernel, dim3(grid), dim3(512), kargs, LDS_BYTES, stream);
    if (e != hipSuccess) fprintf(stderr, "kernel_launch: cooperative launch failed: %s (grid %d)\n", hipGetErrorString(e), grid);
}
```

```cpp
#include <hip/hip_runtime.h>
#include <hip/hip_cooperative_groups.h>
#include <cstdio>
#include <cstdint>
namespace cg = cooperative_groups;

#define LAS __attribute__((address_space(3)))
typedef unsigned short bf16_t;
typedef short bf16x8 __attribute__((ext_vector_type(8)));
typedef short s16x4 __attribute__((ext_vector_type(4)));
typedef float f32x2 __attribute__((ext_vector_type(2)));
typedef float f32x4 __attribute__((ext_vector_type(4)));
typedef float f32x16 __attribute__((ext_vector_type(16)));
typedef unsigned u32x2 __attribute__((ext_vector_type(2)));
typedef unsigned u32x4 __attribute__((ext_vector_type(4)));
typedef __bf16 bf16x2n __attribute__((ext_vector_type(2)));

constexpr int BATCH = 8, SEQ = 8192, D = 1024, DEPTH = 4, NIN = 5632, FF = 4096;
constexpr int M = BATCH * SEQ;
constexpr float LOG2E = 1.4426950408889634f;
constexpr float QSCALE = 0.08838834764831845f * LOG2E;

constexpr size_t MiB = 1u << 20;
constexpr size_t WS_WIN = 0, WS_WOA = 44 * MiB, WS_WOL = 52 * MiB, WS_WOUT = 60 * MiB, WS_WUP = 68 * MiB, WS_WDN = 100 * MiB, WS_WG = 132 * MiB;
constexpr size_t WS_MISC = 136 * MiB, WS_SS = 137 * MiB, WS_AGG = 141 * MiB, WS_CARRY = 157 * MiB, WS_XB = 165 * MiB, WS_P = 293 * MiB;
constexpr size_t P_Q = 0, P_KV = (size_t)M * 1024, P_XR = P_KV + (size_t)M * 512, P_GR = P_XR + (size_t)M * 1024, P_GA = P_GR + (size_t)M * 1024, P_GB = P_GA + (size_t)M * 1024;
constexpr size_t WS_END = WS_P + (P_GB + (size_t)M * 1024) * 2;
static_assert(WS_END == 997 * MiB, "ws map");
constexpr int LDS_BYTES = 163840;
constexpr int LDS_SS = 131072;
constexpr size_t WS_CTL = WS_MISC + 131072, CTL_BYTES = 65536;

__device__ __forceinline__ unsigned pk2(float a, float b) { f32x2 v = {a, b}; bf16x2n r = __builtin_convertvector(v, bf16x2n); return __builtin_bit_cast(unsigned, r); }
__device__ __forceinline__ float bflo(unsigned u) { return __builtin_bit_cast(float, u << 16); }
__device__ __forceinline__ float bfhi(unsigned u) { return __builtin_bit_cast(float, u & 0xffff0000u); }
__device__ __forceinline__ float sigmoidf_(float x) { return __builtin_amdgcn_rcpf(1.f + __expf(-x)); }

namespace pg8 {
constexpr int BM = 256, BK = 64, HALF = 128, HTB = HALF * BK * 2, STAGE_BYTES = 8 * HTB, NXCD = 8, WGM = 8;
__host__ __device__ __forceinline__ int lds_byte(int r, int c) { const int st = (r >> 4) * 2 + (c >> 5), rr = r & 15, cc = c & 31, ob = rr * 64 + cc * 2; return st * 1024 + (ob ^ (((ob >> 9) & 1) << 5)); }
__host__ __device__ __forceinline__ void stage_rc(int b, int& R, int& C) { const int st = b / 1024, sb = b % 1024, swz = sb ^ (((sb >> 9) & 1) << 5); R = (st >> 1) * 16 + swz / 64; C = (st & 1) * 32 + (swz % 64) / 2; }
__host__ __device__ __forceinline__ int perm32(int rho) { const int n = rho >> 4, i = rho & 15; return 8 * (i >> 2) + 4 * n + (i & 3); }

struct Unit { int pm, pn; };
struct Gemm { const bf16_t* A; const bf16_t* Bt; int M, N, K; };

struct StaticOrder {
    int nM, nN, nwg, G, c;
    __host__ __device__ void init(int M_, int N_, int G_, int c_) { nM = M_ / BM; nN = N_ / BM; nwg = nM * nN; G = G_; c = c_; }
    __host__ __device__ bool next(int i, Unit& u) const {
        const long L = (long)i * G + c; if (L >= nwg) return false;
        int wgid = (int)L; { const int q = nwg / NXCD, r = nwg % NXCD, xcd = wgid % NXCD, off = wgid / NXCD; wgid = (xcd < r ? xcd * (q + 1) : r * (q + 1) + (xcd - r) * q) + off; }
        const int nig = WGM * nN, gid = wgid / nig, fm = gid * WGM, gsz = (nM - fm) < WGM ? (nM - fm) : WGM;
        u.pm = fm + ((wgid % nig) % gsz); u.pn = (wgid % nig) / gsz; return true;
    }
};

__device__ __forceinline__ float row_rstd(const float* ss, int row) {
    const f32x4* p = (const f32x4*)(ss + (size_t)row * 16);
    const f32x4 a = p[0], b = p[1], c = p[2], d = p[3];
    const float s = (((a.x + a.y) + (a.z + a.w)) + ((b.x + b.y) + (b.z + b.w))) + (((c.x + c.y) + (c.z + c.w)) + ((d.x + d.y) + (d.z + d.w)));
    return __builtin_amdgcn_rsqf(s * (1.f / 1024.f) + 1e-6f);
}

__device__ __forceinline__ float row_rstd_lds(const LAS unsigned char* img, int rl) {
    const LAS f32x4* p = (const LAS f32x4*)(img + rl * 64);
    const f32x4 a = p[0], b = p[1], c = p[2], d = p[3];
    const float s = (((a.x + a.y) + (a.z + a.w)) + ((b.x + b.y) + (b.z + b.w))) + (((c.x + c.y) + (c.z + c.w)) + ((d.x + d.y) + (d.z + d.w)));
    return __builtin_amdgcn_rsqf(s * (1.f / 1024.f) + 1e-6f);
}
struct EpiIn {
    static constexpr bool PERM = true, RSTD = true;
    bf16_t* P; const float* ss; int pn_off;
    __device__ __forceinline__ void operator()(const f32x4 (&acc)[2][2][4][2], const Unit& u, int wr, int wc, int fr, int fq, const LAS unsigned char* img) const {
        const int pn = u.pn + pn_off; bf16_t* base; int ld; float sc = 1.f;
        if (pn < 4) { base = P + P_Q + pn * 256; ld = 1024; sc = QSCALE; }
        else if (pn < 6) { base = P + P_KV + (pn - 4) * 256; ld = 512; }
        else { const int t = (pn - 6) >> 2, c = (pn - 6) & 3; base = P + P_XR + (size_t)t * ((size_t)M * 1024) + c * 256; ld = 1024; }
        const bool isgate = (pn >= 10 && pn < 14);
        const int row0 = u.pm * BM + wr * 64 + fr, col0 = wc * 32 + 8 * fq;
#pragma unroll
        for (int ai = 0; ai < 2; ++ai)
#pragma unroll
            for (int m = 0; m < 4; ++m) { const int row = row0 + ai * HALF + m * 16; const float rs = row_rstd_lds(img, wr * 64 + fr + ai * HALF + m * 16) * sc; bf16_t* rowp = base + (size_t)row * ld + col0;
#pragma unroll
                for (int bj = 0; bj < 2; ++bj) { f32x4 v0 = acc[ai][bj][m][0] * rs, v1 = acc[ai][bj][m][1] * rs;
                    if (isgate) {
#pragma unroll
                        for (int j = 0; j < 4; ++j) { const float a = v0[j], b = v1[j];
                            v0[j] = a * __builtin_amdgcn_rcpf(1.f + __builtin_amdgcn_exp2f(-1.5957691216057308f * LOG2E * (a + 0.044715f * a * a * a)));
                            v1[j] = b * __builtin_amdgcn_rcpf(1.f + __builtin_amdgcn_exp2f(-1.5957691216057308f * LOG2E * (b + 0.044715f * b * b * b))); } }
                    u32x4 w; w.x = pk2(v0[0], v0[1]); w.y = pk2(v0[2], v0[3]); w.z = pk2(v1[0], v1[1]); w.w = pk2(v1[2], v1[3]);
                    *(u32x4*)(rowp + bj * HALF) = w; } }
    }
};
struct EpiUp {
    static constexpr bool PERM = true, RSTD = true;
    bf16_t* U; const float* ss;
    __device__ __forceinline__ void operator()(const f32x4 (&acc)[2][2][4][2], const Unit& u, int wr, int wc, int fr, int fq, const LAS unsigned char* img) const {
        const int row0 = u.pm * BM + wr * 64 + fr, col0 = u.pn * BM + wc * 32 + 8 * fq;
#pragma unroll
        for (int ai = 0; ai < 2; ++ai)
#pragma unroll
            for (int m = 0; m < 4; ++m) { const int row = row0 + ai * HALF + m * 16; const float rs = row_rstd_lds(img, wr * 64 + fr + ai * HALF + m * 16); bf16_t* rowp = U + (size_t)row * FF + col0;
#pragma unroll
                for (int bj = 0; bj < 2; ++bj) { f32x4 v0 = acc[ai][bj][m][0] * rs, v1 = acc[ai][bj][m][1] * rs;
#pragma unroll
                    for (int j = 0; j < 4; ++j) { const float a = fmaxf(v0[j], 0.f), b = fmaxf(v1[j], 0.f); v0[j] = a * a; v1[j] = b * b; }
                    u32x4 w; w.x = pk2(v0[0], v0[1]); w.y = pk2(v0[2], v0[3]); w.z = pk2(v1[0], v1[1]); w.w = pk2(v1[2], v1[3]);
                    *(u32x4*)(rowp + bj * HALF) = w; } }
    }
};
template <int STAGE> struct EpiGate {
    static constexpr bool PERM = true, RSTD = false;
    bf16_t* GA; const bf16_t* GB; const float* ss;
    __device__ __forceinline__ void operator()(const f32x4 (&acc)[2][2][4][2], const Unit& u, int wr, int wc, int fr, int fq, const LAS unsigned char* img) const {
        const int row0 = u.pm * BM + wr * 64 + fr, col0 = u.pn * BM + wc * 32 + 8 * fq;
#pragma unroll
        for (int ai = 0; ai < 2; ++ai)
#pragma unroll
            for (int m = 0; m < 4; ++m) { const size_t off = (size_t)(row0 + ai * HALF + m * 16) * 1024 + col0;
#pragma unroll
                for (int bj = 0; bj < 2; ++bj) {
                    const u32x4 g = *(const u32x4*)((STAGE == 0 ? (const bf16_t*)GA : GB) + off + bj * HALF);
                    float s[8] = {bflo(g.x), bfhi(g.x), bflo(g.y), bfhi(g.y), bflo(g.z), bfhi(g.z), bflo(g.w), bfhi(g.w)};
                    float o[8];
#pragma unroll
                    for (int j = 0; j < 8; ++j) o[j] = sigmoidf_(s[j]) * acc[ai][bj][m][j >> 2][j & 3];
                    if (STAGE == 1) { const u32x4 t = *(const u32x4*)(GA + off + bj * HALF);
                        o[0] += bflo(t.x); o[1] += bfhi(t.x); o[2] += bflo(t.y); o[3] += bfhi(t.y); o[4] += bflo(t.z); o[5] += bfhi(t.z); o[6] += bflo(t.w); o[7] += bfhi(t.w); }
                    u32x4 w; w.x = pk2(o[0], o[1]); w.y = pk2(o[2], o[3]); w.z = pk2(o[4], o[5]); w.w = pk2(o[6], o[7]);
                    *(u32x4*)(GA + off + bj * HALF) = w; } }
    }
};
struct EpiRes {
    static constexpr bool PERM = true, RSTD = false;
    bf16_t* xb; float* ss;
    __device__ __forceinline__ void operator()(const f32x4 (&acc)[2][2][4][2], const Unit& u, int wr, int wc, int fr, int fq, const LAS unsigned char* img) const {
        const int row0 = u.pm * BM + wr * 64 + fr, col0 = u.pn * BM + wc * 32 + 8 * fq;
#pragma unroll
        for (int ai = 0; ai < 2; ++ai)
#pragma unroll
            for (int m = 0; m < 4; ++m) { const int row = row0 + ai * HALF + m * 16; const size_t off = (size_t)row * 1024 + col0; float sq = 0.f;
#pragma unroll
                for (int bj = 0; bj < 2; ++bj) { const u32x4 t = *(const u32x4*)(xb + off + bj * HALF);
                    float o[8] = {bflo(t.x), bfhi(t.x), bflo(t.y), bfhi(t.y), bflo(t.z), bfhi(t.z), bflo(t.w), bfhi(t.w)};
#pragma unroll
                    for (int j = 0; j < 8; ++j) { o[j] += acc[ai][bj][m][j >> 2][j & 3]; sq += o[j] * o[j]; }
                    u32x4 w; w.x = pk2(o[0], o[1]); w.y = pk2(o[2], o[3]); w.z = pk2(o[4], o[5]); w.w = pk2(o[6], o[7]);
                    *(u32x4*)(xb + off + bj * HALF) = w; }
                sq += __shfl_xor(sq, 16); sq += __shfl_xor(sq, 32);
                if (fq == 0) ss[(size_t)row * 16 + u.pn * 4 + wc] = sq; }
    }
};

template <class Epi>
__device__ __forceinline__ void gemm_phase(LAS unsigned char* lds, const Gemm g, const StaticOrder& S, const Epi& E) {
    int tid = threadIdx.x; asm volatile("" : "+v"(tid));
    const int wid = __builtin_amdgcn_readfirstlane(tid >> 6), lane = tid & 63, wr = wid >> 2, wc = wid & 3, fr = lane & 15, fq = lane >> 4;
    const int K = g.K, nt = K / BK;
    unsigned voffA[2], voffB[2];
#pragma unroll
    for (int i = 0; i < 2; ++i) { int R, C; stage_rc(tid * 16 + i * 8192, R, C); const int Rb = Epi::PERM ? ((R & ~31) + perm32(R & 31)) : R;
        voffA[i] = (unsigned)(R * K + C) * 2u; voffB[i] = (unsigned)(Rb * K + C) * 2u; }
    const size_t kstep = (size_t)(BK * 2);
    const size_t hstep = (size_t)HALF * K * 2;
    const size_t tstep = 2 * hstep;
    const unsigned ldsw = (unsigned)wid * 1024u;
    const int aoff = lds_byte(wr * 64 + fr, fq * 8), boff = lds_byte(wc * 32 + fr, fq * 8);
#define PG8_SA(b, h) (((b) * 2 + (h)) * HTB)
#define PG8_SB(b, h) ((4 + (b) * 2 + (h)) * HTB)
#define PG8_STAGE(bufoff, gbase, voff) do { _Pragma("unroll") for (int _i = 0; _i < 2; ++_i) \
        __builtin_amdgcn_global_load_lds((const unsigned*)((const char*)(gbase) + (voff)[_i]), (LAS unsigned*)(lds + (bufoff) + ldsw + _i * 8192), 16, 0, 0); } while (0)
#define PG8_LDA(dst, b, h) do { _Pragma("unroll") for (int m = 0; m < 4; ++m) _Pragma("unroll") for (int k = 0; k < 2; ++k) dst[m][k] = *(const LAS bf16x8*)(lds + PG8_SA(b, h) + aoff + m * 2048 + k * 1024); } while (0)
#define PG8_LDB(dst, b, h) do { _Pragma("unroll") for (int n = 0; n < 2; ++n) _Pragma("unroll") for (int k = 0; k < 2; ++k) dst[n][k] = *(const LAS bf16x8*)(lds + PG8_SB(b, h) + boff + n * 2048 + k * 1024); } while (0)
#define PG8_MMA(ai, bj, At, Bt) do { __builtin_amdgcn_s_setprio(1); _Pragma("unroll") for (int m = 0; m < 4; ++m) _Pragma("unroll") for (int n = 0; n < 2; ++n) _Pragma("unroll") for (int k = 0; k < 2; ++k) \
        acc[ai][bj][m][n] = __builtin_amdgcn_mfma_f32_16x16x32_bf16(Bt[n][k], At[m][k], acc[ai][bj][m][n], 0, 0, 0); __builtin_amdgcn_s_setprio(0); } while (0)
#define PG8_WAIT_V(n) asm volatile("s_waitcnt vmcnt(" #n ")" ::: "memory")
#define PG8_WAIT_L(n) asm volatile("s_waitcnt lgkmcnt(" #n ")" ::: "memory")
#define PG8_BAR __builtin_amdgcn_s_barrier()
#define PG8_SCHED __builtin_amdgcn_sched_barrier(0)
    Unit cur, nxt; int ui = 0;
    if (!S.next(0, cur)) return;
    f32x4 acc[2][2][4][2];
#pragma unroll
    for (int a = 0; a < 2; ++a)
#pragma unroll
        for (int b = 0; b < 2; ++b)
#pragma unroll
            for (int m = 0; m < 4; ++m)
#pragma unroll
                for (int n = 0; n < 2; ++n) acc[a][b][m][n] = (f32x4){0.f, 0.f, 0.f, 0.f};
    bf16x8 At[4][2], B0[2][2], B1[2][2];
    const char* cA = (const char*)g.A + (size_t)cur.pm * tstep; const char* cB = (const char*)g.Bt + (size_t)cur.pn * tstep;
    PG8_STAGE(PG8_SB(0, 0), cB, voffB); PG8_STAGE(PG8_SB(0, 1), cB + hstep, voffB); PG8_STAGE(PG8_SA(0, 0), cA, voffA); PG8_STAGE(PG8_SA(0, 1), cA + hstep, voffA);
    if (wr == 1) PG8_BAR;
    PG8_WAIT_V(2); PG8_BAR;
    PG8_STAGE(PG8_SB(1, 0), cB + kstep, voffB); PG8_STAGE(PG8_SA(1, 0), cA + kstep, voffA); PG8_STAGE(PG8_SB(1, 1), cB + hstep + kstep, voffB);
    PG8_WAIT_V(6); PG8_BAR;
    for (;;) {
        const bool has_next = S.next(ui + 1, nxt);
        const char* nA = has_next ? (const char*)g.A + (size_t)nxt.pm * tstep : cA; const char* nB = has_next ? (const char*)g.Bt + (size_t)nxt.pn * tstep : cB;
        LAS unsigned char* img = lds + LDS_SS + (ui & 1) * 16384;
        if constexpr (Epi::RSTD) {
#pragma unroll
            for (int i = 0; i < 2; ++i) __builtin_amdgcn_global_load_lds((const unsigned*)(E.ss + ((size_t)cur.pm * BM) * 16 + (size_t)(tid + 512 * i) * 4), (LAS unsigned*)(img + wid * 1024 + i * 8192), 16, 0, 0);
        }
        for (int t = 0; t < nt; t += 2) {
            const bool last = (t == nt - 2);
            const char* a1 = cA + (size_t)(t + 1) * kstep;
            const char* a2 = last ? nA : cA + (size_t)(t + 2) * kstep; const char* b2 = last ? nB : cB + (size_t)(t + 2) * kstep;
            const char* a3 = a2 + kstep; const char* b3 = b2 + kstep;
            PG8_LDB(B0, 0, 0); PG8_LDB(B1, 0, 1); PG8_SCHED; PG8_LDA(At, 0, 0); PG8_STAGE(PG8_SA(1, 1), a1 + hstep, voffA);
            PG8_WAIT_V(8); PG8_WAIT_L(0); PG8_BAR; PG8_MMA(0, 0, At, B0); PG8_MMA(0, 1, At, B1); PG8_BAR; PG8_SCHED;
            PG8_LDA(At, 0, 1); PG8_STAGE(PG8_SB(0, 0), b2, voffB); PG8_STAGE(PG8_SB(0, 1), b2 + hstep, voffB); PG8_STAGE(PG8_SA(0, 0), a2, voffA);
            PG8_WAIT_V(8); PG8_WAIT_L(0); PG8_BAR; PG8_MMA(1, 0, At, B0); PG8_MMA(1, 1, At, B1); PG8_BAR; PG8_SCHED;
            PG8_LDB(B0, 1, 0); PG8_LDB(B1, 1, 1); PG8_SCHED; PG8_LDA(At, 1, 0); PG8_STAGE(PG8_SA(0, 1), a2 + hstep, voffA);
            PG8_WAIT_V(8); PG8_WAIT_L(0); PG8_BAR; PG8_MMA(0, 0, At, B0); PG8_MMA(0, 1, At, B1); PG8_BAR; PG8_SCHED;
            PG8_LDA(At, 1, 1); PG8_STAGE(PG8_SB(1, 0), b3, voffB); PG8_STAGE(PG8_SB(1, 1), b3 + hstep, voffB); PG8_STAGE(PG8_SA(1, 0), a3, voffA);
            PG8_WAIT_V(8); PG8_WAIT_L(0); PG8_BAR; PG8_MMA(1, 0, At, B0); PG8_MMA(1, 1, At, B1); PG8_BAR; PG8_SCHED;
        }
        if (wr == 0) PG8_BAR;
        E(acc, cur, wr, wc, fr, fq, img);
        if (!has_next) break;
#pragma unroll
        for (int a = 0; a < 2; ++a)
#pragma unroll
            for (int b = 0; b < 2; ++b)
#pragma unroll
                for (int m = 0; m < 4; ++m)
#pragma unroll
                    for (int n = 0; n < 2; ++n) acc[a][b][m][n] = (f32x4){0.f, 0.f, 0.f, 0.f};
        cur = nxt; cA = nA; cB = nB; ++ui;
        if (wr == 1) PG8_BAR;
    }
    PG8_WAIT_V(0);
    PG8_BAR;
#undef PG8_SA
#undef PG8_SB
#undef PG8_STAGE
#undef PG8_LDA
#undef PG8_LDB
#undef PG8_MMA
#undef PG8_WAIT_V
#undef PG8_WAIT_L
#undef PG8_BAR
#undef PG8_SCHED
}
}

struct Args { const float* in[19]; float* out; unsigned char* ws; };

__device__ __forceinline__ float wave_sum(float v) {
#pragma unroll
    for (int o = 1; o < 64; o <<= 1) v += __shfl_xor(v, o);
    return v;
}

__device__ __forceinline__ void transpose_item(const float* W, int K, int N, bf16_t* WT, const float* gain, LAS float* scr, int item, int lane) {
    const int nblk = N / 32, kb = item / nblk, nb = item % nblk, k0 = 64 * kb, n0 = 32 * nb;
    { const int ksub = lane >> 3, n4 = (lane & 7) * 4; f32x4 v[8];
#pragma unroll
      for (int j = 0; j < 8; ++j) v[j] = *(const f32x4*)(W + (size_t)(k0 + 8 * j + ksub) * N + n0 + n4);
#pragma unroll
      for (int j = 0; j < 8; ++j) { const int kk = 8 * j + ksub; const float gsc = gain ? gain[k0 + kk] : 1.f;
          scr[kk * 33 + n4] = v[j].x * gsc; scr[kk * 33 + n4 + 1] = v[j].y * gsc; scr[kk * 33 + n4 + 2] = v[j].z * gsc; scr[kk * 33 + n4 + 3] = v[j].w * gsc; } }
    asm volatile("s_waitcnt lgkmcnt(0)" ::: "memory");
    const int c = lane & 7;
#pragma unroll
    for (int j = 0; j < 4; ++j) { const int n = (lane >> 3) + 8 * j; const LAS float* s = scr + (8 * c) * 33 + n;
        u32x4 o; o.x = pk2(s[0 * 33], s[1 * 33]); o.y = pk2(s[2 * 33], s[3 * 33]); o.z = pk2(s[4 * 33], s[5 * 33]); o.w = pk2(s[6 * 33], s[7 * 33]);
        *(u32x4*)(WT + (size_t)(n0 + n) * K + k0 + 8 * c) = o; }
    asm volatile("s_waitcnt lgkmcnt(0)" ::: "memory");
}
__device__ __forceinline__ void transpose_all(const float* W, int K, int N, bf16_t* WT, const float* gain, LAS float* scr, int gw, int NGW, int lane) {
    const int items = (K / 64) * (N / 32);
    for (int it = gw; it < items; it += NGW) transpose_item(W, K, N, WT, gain, scr, it, lane);
}

__device__ __forceinline__ int t5_bucket(int rel) {
    const int n = rel < 0 ? -rel : rel; int bk;
    if (n < 8) bk = n; else { int j = (31 - __clz(n * n)) - 6; bk = 8 + j; if (bk > 15) bk = 15; }
    return bk + (rel > 0 ? 16 : 0);
}

constexpr int KP = 272;
__device__ __forceinline__ void attn_phase(LAS unsigned char* lds, bf16_t* Q, const bf16_t* KV, const float* biasT, const float* sink, unsigned* queue) {
    int tid = threadIdx.x; asm volatile("" : "+v"(tid));
    const int wave = __builtin_amdgcn_readfirstlane(tid >> 6), lane = tid & 63, r = lane & 31, h = lane >> 5;
    LAS unsigned char* Kb = lds; LAS unsigned char* Vb = lds + 128 * KP; LAS float* bt = (LAS float*)(lds + 2 * 128 * KP);
    const int qt = wave & 3, hl = wave >> 2;
    LAS int* qslot = (LAS int*)(lds + 2 * 128 * KP + 16384);
    LAS unsigned char* ostage = lds + 90112 + wave * (32 * KP);
    __syncthreads();
    for (int e = tid; e < 4096; e += 512) bt[e] = biasT[e];
    if (tid == 0) qslot[0] = (int)__hip_atomic_fetch_add(queue, 1u, __ATOMIC_RELAXED, __HIP_MEMORY_SCOPE_AGENT);
    __syncthreads();
    int item = qslot[0];
    while (item < BATCH * 64 * 4) {
        int nxt = 0;
        if (tid == 0) nxt = (int)__hip_atomic_fetch_add(queue, 1u, __ATOMIC_RELAXED, __HIP_MEMORY_SCOPE_AGENT);
        const int hp = item & 1, kvh = (item >> 1) & 1, qi = (item >> 2) & 63, b = item >> 8;
        const int head = kvh * 4 + hp * 2 + hl;
        const size_t qrow = (size_t)b * SEQ + qi * 128 + qt * 32 + r;
        bf16x8 qf[8];
#pragma unroll
        for (int ks = 0; ks < 8; ++ks) qf[ks] = *(const bf16x8*)(Q + qrow * 1024 + head * 128 + 16 * ks + 8 * h);
        const float sink2 = sink[head] * LOG2E;
        float mrun = sink2, lrun = 0.f;
        f32x16 O[4];
#pragma unroll
        for (int dt = 0; dt < 4; ++dt)
#pragma unroll
            for (int i = 0; i < 16; ++i) O[dt][i] = 0.f;
        u32x4 kreg[4], vreg[4];
        const int kb_lo = qi > 0 ? -1 : 0, kb_hi = qi < 63 ? 1 : 0;
#define ATT_LOAD(kbv) do { const bf16_t* kbase = KV + ((size_t)b * SEQ + (qi + (kbv)) * 128) * 512 + kvh * 128; \
            _Pragma("unroll") for (int c = 0; c < 4; ++c) { const int ch = tid + 512 * c, row = ch >> 4, c16 = ch & 15; \
                kreg[c] = *(const u32x4*)(kbase + (size_t)row * 512 + c16 * 8); vreg[c] = *(const u32x4*)(kbase + (size_t)row * 512 + 256 + c16 * 8); } } while (0)
        ATT_LOAD(kb_lo);
#pragma unroll 1
        for (int kb = kb_lo; kb <= kb_hi; ++kb) {
            __syncthreads();
#pragma unroll
            for (int c = 0; c < 4; ++c) { const int ch = tid + 512 * c, row = ch >> 4, c16 = ch & 15;
                *(LAS u32x4*)(Kb + row * KP + c16 * 16) = kreg[c]; *(LAS u32x4*)(Vb + row * KP + c16 * 16) = vreg[c]; }
            __syncthreads();
            if (kb < kb_hi) ATT_LOAD(kb + 1);
#pragma unroll 1
            for (int sub = 0; sub < 2; ++sub) {
                if (kb == -1 && sub == 0 && qt >= 2) continue;
                if (kb == 1 && sub == 1 && qt <= 1) continue;
                f32x16 sa[2];
#pragma unroll
                for (int i = 0; i < 16; ++i) { sa[0][i] = 0.f; sa[1][i] = 0.f; }
#pragma unroll
                for (int kt = 0; kt < 2; ++kt) {
                    bf16x8 kf[8];
#pragma unroll
                    for (int ks = 0; ks < 8; ++ks) kf[ks] = *(const LAS bf16x8*)(Kb + (64 * sub + 32 * kt + r) * KP + (16 * ks + 8 * h) * 2);
                    __builtin_amdgcn_sched_barrier(0);
#pragma unroll
                    for (int ks = 0; ks < 8; ++ks) sa[kt] = __builtin_amdgcn_mfma_f32_32x32x16_bf16(kf[ks], qf[ks], sa[kt], 0, 0, 0);
                    __builtin_amdgcn_sched_barrier(0);
                }
                const LAS float* btl = bt + head * 512 + (kb * 128 + 64 * sub + 4 * h - 32 * qt - r + 256);
                float mx = -3.0e38f;
#pragma unroll
                for (int kt = 0; kt < 2; ++kt) { float bv[16];
#pragma unroll
                    for (int i = 0; i < 16; ++i) bv[i] = btl[32 * kt + (i & 3) + 8 * (i >> 2)];
#pragma unroll
                    for (int i = 0; i < 16; ++i) { const float sv = sa[kt][i] + bv[i]; sa[kt][i] = sv; mx = fmaxf(mx, sv); } }
                mx = fmaxf(mx, __shfl_xor(mx, 32));
                const float mnew = fmaxf(mrun, mx), alpha = __builtin_amdgcn_exp2f(mrun - mnew);
                const bool grew = mnew > mrun;
                mrun = mnew; lrun *= alpha;
                if (__builtin_amdgcn_ballot_w64(grew) != 0ull) {
#pragma unroll
                    for (int dt = 0; dt < 4; ++dt)
#pragma unroll
                        for (int i = 0; i < 16; ++i) O[dt][i] *= alpha; }
                float ls = 0.f;
#pragma unroll
                for (int kt = 0; kt < 2; ++kt)
#pragma unroll
                    for (int i = 0; i < 16; ++i) { const float p = __builtin_amdgcn_exp2f(sa[kt][i] - mnew); sa[kt][i] = p; ls += p; }
                lrun += ls;
#pragma unroll
                for (int kt = 0; kt < 2; ++kt)
#pragma unroll
                    for (int s2 = 0; s2 < 2; ++s2) {
                        u32x4 pw; pw.x = pk2(sa[kt][8 * s2 + 0], sa[kt][8 * s2 + 1]); pw.y = pk2(sa[kt][8 * s2 + 2], sa[kt][8 * s2 + 3]); pw.z = pk2(sa[kt][8 * s2 + 4], sa[kt][8 * s2 + 5]); pw.w = pk2(sa[kt][8 * s2 + 6], sa[kt][8 * s2 + 7]);
                        const bf16x8 pf = __builtin_bit_cast(bf16x8, pw);
                        const int key0 = 64 * sub + 32 * kt + 16 * s2 + 4 * h + ((lane & 15) >> 2);
                        const LAS unsigned char* vp = Vb + key0 * KP + ((lane >> 4) & 1) * 32 + (lane & 3) * 8;
                        s16x4 lo[4], hi[4];
#pragma unroll
                        for (int dt = 0; dt < 4; ++dt) { lo[dt] = __builtin_amdgcn_ds_read_tr16_b64_v4i16((LAS s16x4*)(vp + dt * 64)); hi[dt] = __builtin_amdgcn_ds_read_tr16_b64_v4i16((LAS s16x4*)(vp + 8 * KP + dt * 64)); }
#pragma unroll
                        for (int dt = 0; dt < 4; ++dt) {
                            const bf16x8 va = __builtin_shufflevector(lo[dt], hi[dt], 0, 1, 2, 3, 4, 5, 6, 7);
                            O[dt] = __builtin_amdgcn_mfma_f32_32x32x16_bf16(va, pf, O[dt], 0, 0, 0); } }
            }
        }
#undef ATT_LOAD
        const float ltot = lrun + __shfl_xor(lrun, 32) + __builtin_amdgcn_exp2f(sink2 - mrun);
        const float inv = 1.f / ltot;
#pragma unroll
        for (int dt = 0; dt < 4; ++dt)
#pragma unroll
            for (int g4 = 0; g4 < 4; ++g4) { u32x2 w; w.x = pk2(O[dt][4 * g4] * inv, O[dt][4 * g4 + 1] * inv); w.y = pk2(O[dt][4 * g4 + 2] * inv, O[dt][4 * g4 + 3] * inv);
                *(LAS u32x2*)(ostage + r * KP + (32 * dt + 8 * g4 + 4 * h) * 2) = w; }
        bf16_t* obase = Q + ((size_t)b * SEQ + qi * 128 + qt * 32) * 1024 + head * 128;
#pragma unroll
        for (int i = 0; i < 8; ++i) { const int c = lane + 64 * i, row = c >> 4, c16 = c & 15;
            const u32x4 w = *(const LAS u32x4*)(ostage + row * KP + c16 * 16);
            *(u32x4*)(obase + (size_t)row * 1024 + c16 * 8) = w; }
        if (tid == 0) qslot[0] = nxt;
        __syncthreads();
        item = qslot[0];
    }
    __syncthreads();
}

constexpr int LRU_T = 128, LRU_NCH = SEQ / LRU_T, LRU_TASKS = BATCH * 8 * 2;
constexpr int XCF_P = 68, RAW_P = 256;
constexpr int LRU_RAW0 = 0, LRU_RAW1 = LRU_T * RAW_P, LRU_XCF = 2 * LRU_T * RAW_P, LRU_GATE = LRU_XCF + LRU_T * XCF_P * 4, LRU_PF = LRU_GATE + LRU_T * 128, LRU_EX = LRU_PF + LRU_T * 128;
static_assert(LRU_EX + 2 * 64 * 2 * 4 <= LDS_BYTES, "lru lds");
__device__ __forceinline__ float neg_expm1(float x, float a) {
    float p = 1.f + x * 0.2f; p = 1.f + x * 0.25f * p; p = 1.f + x * (1.f / 3.f) * p; p = 1.f + x * 0.5f * p;
    const float small = -x * p, big = __builtin_fmaf(-a, a, 1.f);
    return x < -0.25f ? big : small;
}
constexpr int XC_T = 128;
__device__ __forceinline__ void xc_produce(const bf16_t* XR, bf16_t* XC, const float* conv_w, const float* conv_b, unsigned* flags, unsigned ready, int pw, int NP) {
    int tid = threadIdx.x; asm volatile("" : "+v"(tid));
    const int c8t = tid & 15, tg = tid >> 4;
    const __amdgpu_buffer_rsrc_t xrs = __builtin_amdgcn_make_buffer_rsrc(XC, 0, (int)((size_t)M * 1024 * 2), 0x00020000);
    constexpr int NJ = 64 * (SEQ / XC_T), NJB = 4;
    u32x4 xv[NJB][7];
#define XC_LOAD(u, jj) do { const int c_ = (jj) >> 6, p_ = (jj) & 63; const size_t base_ = ((size_t)(p_ >> 3) * SEQ) * 1024 + (size_t)(p_ & 7) * 128 + c8t * 8; \
        _Pragma("unroll") for (int rr = 0; rr < 7; ++rr) { int sq = c_ * XC_T + 4 * tg + rr - 2; sq = sq < 0 ? 0 : (sq >= SEQ ? SEQ - 1 : sq); \
            xv[u][rr] = *(const u32x4*)(XR + base_ + (size_t)sq * 1024); } } while (0)
    int pprev = -1; float cwr[5][8];
#pragma unroll
    for (int q = 0; q < 5; ++q)
#pragma unroll
        for (int k = 0; k < 8; ++k) cwr[q][k] = 0.f;
#pragma unroll
    for (int u = 0; u < NJB; ++u) { const int jj = pw + u * NP; XC_LOAD(u, (jj < NJ ? jj : pw)); }
    for (int j = pw; j < NJ; j += NJB * NP) {
#pragma unroll
        for (int u = 0; u < NJB; ++u) {
            const int jj = j + u * NP;
            if (jj < NJ) {
                const int c = jj >> 6, pair = jj & 63, b = pair >> 3, n = pair & 7;
                const size_t col = (size_t)n * 128 + c8t * 8;
                if (pair != pprev) {
#pragma unroll
                    for (int q = 0; q < 5; ++q) { const float* src = (q < 4 ? conv_w + q * 1024 : conv_b) + col; const f32x4 w0 = *(const f32x4*)src, w1 = *(const f32x4*)(src + 4);
                        cwr[q][0] = w0.x; cwr[q][1] = w0.y; cwr[q][2] = w0.z; cwr[q][3] = w0.w; cwr[q][4] = w1.x; cwr[q][5] = w1.y; cwr[q][6] = w1.z; cwr[q][7] = w1.w; }
                    pprev = pair; }
#pragma unroll
                for (int i = 0; i < 4; ++i) { const int t = 4 * tg + i;
                    float xc[8];
#pragma unroll
                    for (int k = 0; k < 8; ++k) xc[k] = cwr[4][k];
#pragma unroll
                    for (int q = 0; q < 4; ++q) { const int sq = c * XC_T + t + q - 2; u32x4 v = xv[u][i + q]; if (sq < 0 || sq >= SEQ) v = (u32x4){0u, 0u, 0u, 0u};
                        xc[0] += bflo(v.x) * cwr[q][0]; xc[1] += bfhi(v.x) * cwr[q][1]; xc[2] += bflo(v.y) * cwr[q][2]; xc[3] += bfhi(v.y) * cwr[q][3];
                        xc[4] += bflo(v.z) * cwr[q][4]; xc[5] += bfhi(v.z) * cwr[q][5]; xc[6] += bflo(v.w) * cwr[q][6]; xc[7] += bfhi(v.w) * cwr[q][7]; }
                    u32x4 w; w.x = pk2(xc[0], xc[1]); w.y = pk2(xc[2], xc[3]); w.z = pk2(xc[4], xc[5]); w.w = pk2(xc[6], xc[7]);
                    __builtin_amdgcn_raw_buffer_store_b128(w, xrs, (unsigned)((((size_t)b * SEQ + c * XC_T + t) * 1024 + col) * 2), 0,   16); } }
        }
        if (j + NJB * NP < NJ) {
#pragma unroll
            for (int u = 0; u < NJB; ++u) { const int jn = j + (NJB + u) * NP; XC_LOAD(u, (jn < NJ ? jn : j + NJB * NP)); }
            asm volatile("s_waitcnt vmcnt(44)" ::: "memory"); }
        else asm volatile("s_waitcnt vmcnt(0)" ::: "memory");
        __syncthreads();
        if (tid == 0 && j >= pw + NJB * NP) {
#pragma unroll
            for (int u = 0; u < NJB; ++u) { const int jp = j - NJB * NP + u * NP; if (jp < NJ) __hip_atomic_store(flags + 64 * (jp & 63) + (jp >> 6), ready, __ATOMIC_RELAXED, __HIP_MEMORY_SCOPE_AGENT); } }
    }
    asm volatile("s_waitcnt vmcnt(0)" ::: "memory");
    __syncthreads();
    if (tid == 0 && pw < NJ) { int jl = pw; while (jl + NJB * NP < NJ) jl += NJB * NP;
#pragma unroll
        for (int u = 0; u < NJB; ++u) { const int jp = jl + u * NP; if (jp < NJ) __hip_atomic_store(flags + 64 * (jp & 63) + (jp >> 6), ready, __ATOMIC_RELAXED, __HIP_MEMORY_SCOPE_AGENT); } }
#undef XC_LOAD
}
__device__ __forceinline__ void lru_stream(LAS unsigned char* lds, const bf16_t* XR, bf16_t* GR, bf16_t* T1, bf16_t* XC, const float* conv_w, const float* conv_b, const bf16_t* WG, const float* b_r, const float* b_i,
                                           const float* lam, int task, unsigned* flags, unsigned ready) {
    int tid = threadIdx.x; asm volatile("" : "+v"(tid));
    const int wave = __builtin_amdgcn_readfirstlane(tid >> 6), lane = tid & 63, chl = lane & 15, qd = lane >> 4, cg = wave & 3, th = wave >> 2;
    LAS float* xcf = (LAS float*)(lds + LRU_XCF); LAS unsigned char* gtl = lds + LRU_GATE; LAS unsigned char* pfl = lds + LRU_PF; LAS float* ex = (LAS float*)(lds + LRU_EX);
    const int b = task >> 4, n = (task >> 1) & 7, h2 = task & 1;
    const int chh = cg * 16 + chl, chb = h2 * 64 + chh, ch = n * 128 + chb;
    const int c8t = tid & 15; const bool own = (c8t >> 3) == h2;
    const size_t colg = (size_t)n * 128 + h2 * 64;
    __syncthreads();
#define LRU_LOAD_XC(cc) do { _Pragma("unroll") for (int i = 0; i < 4; ++i) { const int e = tid + 512 * i, rr = e >> 4, key = ((rr >> 4) & 3) * 4 + (rr & 3); \
            __builtin_amdgcn_global_load_lds((const unsigned*)(XC + ((size_t)b * SEQ + (cc) * LRU_T + rr) * 1024 + n * 128 + ((e & 15) ^ key) * 8), (LAS unsigned*)(lds + ((cc) & 1) * (LRU_T * RAW_P) + wave * 1024 + i * 8192), 16, 0, 0); } } while (0)
#define LRU_LOAD_TILE(src, dstl, cc) do { _Pragma("unroll") for (int i = 0; i < 2; ++i) { const int e = tid + 512 * i; \
            __builtin_amdgcn_global_load_lds((const unsigned*)((src) + ((size_t)b * SEQ + (cc) * LRU_T + (e >> 3)) * 1024 + colg + (e & 7) * 8), (LAS unsigned*)((dstl) + wave * 1024 + i * 8192), 16, 0, 0); } } while (0)
#pragma unroll
    for (int dir = 0; dir < 2; ++dir) {
        bf16x8 bw[2][4];
#pragma unroll
        for (int gi = 0; gi < 2; ++gi)
#pragma unroll
            for (int ks = 0; ks < 4; ++ks) bw[gi][ks] = *(const bf16x8*)(WG + ((size_t)((dir * 2 + gi) * 8 + n) * 128 + chb) * 128 + 32 * ks + 8 * qd);
        const float nbr = -LOG2E * b_r[dir * 1024 + ch], nbi = -LOG2E * b_i[dir * 1024 + ch], cl2 = -8.f * LOG2E * log1pf(expf(-lam[dir * 1024 + ch]));
        float hcar = 0.f;
        unsigned* fl = flags + 64 * (task >> 1);
        if (!dir && tid == 0) {
            for (int k = 0; k < 8; ++k) while (__hip_atomic_load(fl + k, __ATOMIC_RELAXED, __HIP_MEMORY_SCOPE_AGENT) < ready) __builtin_amdgcn_s_sleep(2);
            __builtin_amdgcn_fence(__ATOMIC_ACQUIRE, "agent"); asm volatile("s_waitcnt vmcnt(0)" ::: "memory"); }
        __syncthreads();
        LRU_LOAD_XC(dir ? LRU_NCH - 1 : 0);
        u32x4 gcur[2], pcur[2], gnxt[2], pnxt[2];
#pragma unroll
        for (int i = 0; i < 2; ++i) { gcur[i] = (u32x4){0u, 0u, 0u, 0u}; pcur[i] = gcur[i]; gnxt[i] = gcur[i]; pnxt[i] = gcur[i]; }
#define LRU_LOAD_GP(gd, pd, cc) do { _Pragma("unroll") for (int i = 0; i < 2; ++i) { const int e = tid + 512 * i; const size_t o_ = ((size_t)b * SEQ + (cc) * LRU_T + (e >> 3)) * 1024 + colg + (e & 7) * 8; \
            gd[i] = *(const u32x4*)(GR + o_); pd[i] = *(const u32x4*)(T1 + o_); } } while (0)
        if (dir) LRU_LOAD_GP(gcur, pcur, LRU_NCH - 1);
#pragma unroll 1
        for (int it = 0; it < LRU_NCH; ++it) {
            const int c = dir ? LRU_NCH - 1 - it : it;
            const size_t row0 = (size_t)b * SEQ + c * LRU_T;
            if (!dir && ((c + 1) & 7) == 0 && it + 1 < LRU_NCH && tid == 0) {
                for (int k = 1; k <= 8; ++k) while (__hip_atomic_load(fl + c + k, __ATOMIC_RELAXED, __HIP_MEMORY_SCOPE_AGENT) < ready) __builtin_amdgcn_s_sleep(2);
                __builtin_amdgcn_fence(__ATOMIC_ACQUIRE, "agent"); asm volatile("s_waitcnt vmcnt(0)" ::: "memory"); }
            if (it == 0) asm volatile("s_waitcnt vmcnt(0)" ::: "memory"); else if (dir) asm volatile("s_waitcnt vmcnt(6)" ::: "memory"); else asm volatile("s_waitcnt vmcnt(2)" ::: "memory");
            __syncthreads();
            if (it + 1 < LRU_NCH) LRU_LOAD_XC(dir ? c - 1 : c + 1);
            if (dir && it + 1 < LRU_NCH) LRU_LOAD_GP(gnxt, pnxt, c - 1);
            const LAS unsigned char* img = lds + (c & 1) * (LRU_T * RAW_P);
            f32x4 acc[2][4];
#pragma unroll
            for (int gi = 0; gi < 2; ++gi)
#pragma unroll
                for (int mt = 0; mt < 4; ++mt) acc[gi][mt] = (f32x4){0.f, 0.f, 0.f, 0.f};
#pragma unroll
            for (int ks = 0; ks < 4; ++ks) {
                bf16x8 af[4];
#pragma unroll
                for (int mt = 0; mt < 4; ++mt) { const int tok = th * 64 + (chl >> 2) * 16 + 4 * mt + (chl & 3); af[mt] = *(const LAS bf16x8*)(img + tok * RAW_P + (((4 * ks + qd) ^ chl) << 4)); }
#pragma unroll
                for (int gi = 0; gi < 2; ++gi)
#pragma unroll
                    for (int mt = 0; mt < 4; ++mt) acc[gi][mt] = __builtin_amdgcn_mfma_f32_16x16x32_bf16(af[mt], bw[gi][ks], acc[gi][mt], 0, 0, 0);
            }
#pragma unroll
            for (int mt = 0; mt < 4; ++mt)
#pragma unroll
                for (int j = 0; j < 4; ++j) { const float x = __builtin_bit_cast(float, (unsigned)*(const LAS unsigned short*)(img + (th * 64 + qd * 16 + 4 * mt + j) * RAW_P + ((((chb >> 3) ^ (4 * qd)) ^ j) << 4) + (chb & 7) * 2) << 16);
                    const float e1 = __builtin_amdgcn_exp2f(__builtin_fmaf(acc[0][mt][j], -LOG2E, nbr)), e2 = __builtin_amdgcn_exp2f(__builtin_fmaf(acc[1][mt][j], -LOG2E, nbi));
                    const float rg = __builtin_amdgcn_rcpf(1.f + e1), ig = __builtin_amdgcn_rcpf(1.f + e2);
                    const float a = __builtin_amdgcn_exp2f(rg * cl2), mult = __builtin_amdgcn_sqrtf(__builtin_fmaf(-a, a, 1.f));
                    acc[0][mt][j] = a; acc[1][mt][j] = mult * ig * x; }
            float As = 1.f, Hs = 0.f;
#pragma unroll
            for (int kk = 0; kk < 16; ++kk) { const int k = dir ? 15 - kk : kk; const float a = acc[0][k >> 2][k & 3], u = acc[1][k >> 2][k & 3]; As *= a; Hs = a * Hs + u; }
            float Aq[4], Hq[4];
#pragma unroll
            for (int q = 0; q < 4; ++q) { Aq[q] = __shfl(As, chl + 16 * q); Hq[q] = __shfl(Hs, chl + 16 * q); }
            float Aw = 1.f, Hw = 0.f;
#pragma unroll
            for (int qq = 0; qq < 4; ++qq) { const int q = dir ? 3 - qq : qq; Aw *= Aq[q]; Hw = Aq[q] * Hw + Hq[q]; }
            if (qd == 0) { ex[(th * 64 + chh) * 2] = Aw; ex[(th * 64 + chh) * 2 + 1] = Hw; }
            __syncthreads();
            const float Ao = ex[((1 - th) * 64 + chh) * 2], Ho = ex[((1 - th) * 64 + chh) * 2 + 1];
            const bool first = (th == dir);
            const float A1 = first ? Aw : Ao, H1 = first ? Hw : Ho, A2 = first ? Ao : Aw, H2 = first ? Ho : Hw;
            const float hmid = A1 * hcar + H1;
            float h = first ? hcar : hmid;
            hcar = A2 * hmid + H2;
#pragma unroll
            for (int qq = 0; qq < 3; ++qq) { const int q = dir ? 3 - qq : qq; if (dir ? (q > qd) : (q < qd)) h = Aq[q] * h + Hq[q]; }
#pragma unroll
            for (int kk = 0; kk < 16; ++kk) { const int k = dir ? 15 - kk : kk; h = acc[0][k >> 2][k & 3] * h + acc[1][k >> 2][k & 3]; xcf[(th * 64 + qd * 16 + k) * XCF_P + chh] = h; }
            __syncthreads();
#pragma unroll
            for (int i = 0; i < 2; ++i) { const int e = tid + 512 * i, t = e >> 3, c8 = e & 7;
                const u32x4 gv = gcur[i]; const f32x4 y0 = *(const LAS f32x4*)(xcf + t * XCF_P + c8 * 8), y1 = *(const LAS f32x4*)(xcf + t * XCF_P + c8 * 8 + 4);
                float o[8] = {y0.x, y0.y, y0.z, y0.w, y1.x, y1.y, y1.z, y1.w};
                if (dir) { const u32x4 pv = pcur[i];
                    o[0] += bflo(pv.x); o[1] += bfhi(pv.x); o[2] += bflo(pv.y); o[3] += bfhi(pv.y); o[4] += bflo(pv.z); o[5] += bfhi(pv.z); o[6] += bflo(pv.w); o[7] += bfhi(pv.w);
                    const float gg[8] = {bflo(gv.x), bfhi(gv.x), bflo(gv.y), bfhi(gv.y), bflo(gv.z), bfhi(gv.z), bflo(gv.w), bfhi(gv.w)};
#pragma unroll
                    for (int j = 0; j < 8; ++j) o[j] *= gg[j]; }
                u32x4 w; w.x = pk2(o[0], o[1]); w.y = pk2(o[2], o[3]); w.z = pk2(o[4], o[5]); w.w = pk2(o[6], o[7]);
                *(u32x4*)((dir ? GR : T1) + (row0 + t) * 1024 + colg + c8 * 8) = w; }
            if (dir) {
#pragma unroll
                for (int i = 0; i < 2; ++i) { gcur[i] = gnxt[i]; pcur[i] = pnxt[i]; } }
        }
    }
#undef LRU_LOAD_XC
#undef LRU_LOAD_TILE
#undef LRU_LOAD_GP
    asm volatile("s_waitcnt vmcnt(0)" ::: "memory");
    __syncthreads();
}
#define XB_TMO      128
#define XB_XCNT(j)  (256  + 64 * (j))
#define XB_XSUB(j)  (1280 + 64 * (j))
#define XB_XGEN(j)  (2304 + 64 * (j))
#define XB_TOP      3328
#define XB_TOPGEN   3392
#define XCD_BAR_WORDS 3456
#define XB_SPIN_CAP (1u << 22)
__device__ __forceinline__ unsigned xb_ld(unsigned* p)              { return __hip_atomic_load(p, __ATOMIC_RELAXED, __HIP_MEMORY_SCOPE_AGENT); }
__device__ __forceinline__ unsigned xb_add(unsigned* p, unsigned v) { return __hip_atomic_fetch_add(p, v, __ATOMIC_RELAXED, __HIP_MEMORY_SCOPE_AGENT); }
__device__ __forceinline__ unsigned xb_xcc_id() { return (unsigned)__builtin_amdgcn_s_getreg((3 << 11) | 20) & 0xFu; }
#define XB_SPIN(cond, bar) do { unsigned _sp = 0; while (cond) { __builtin_amdgcn_s_sleep(1); \
    if ((++_sp & 255u) == 0u) { if (xb_ld(&(bar)[XB_TMO])) break; if (_sp > XB_SPIN_CAP) { atomicAdd(&(bar)[XB_TMO], 1u); break; } } } } while (0)
struct XcdBarrier { unsigned* bar; unsigned x; };
__device__ __forceinline__ XcdBarrier xcd_barrier_post(unsigned* bar) {
    XcdBarrier b; b.bar = bar; b.x = xb_xcc_id();
    if (threadIdx.x == 0) (void)xb_add(&bar[XB_XCNT(b.x)], 1u);
    return b;
}
__device__ __forceinline__ void xcd_barrier_complete(unsigned* bar, unsigned x, unsigned& nloc, unsigned& nx) {
    const unsigned G = gridDim.x * gridDim.y * gridDim.z;
    unsigned sum, cnt, mine, sp = 0u;
    for (;;) {
        sum = 0u; cnt = 0u; mine = 0u;
#pragma unroll
        for (unsigned j = 0; j < 16; ++j) { const unsigned c = xb_ld(&bar[XB_XCNT(j)]); sum += c; cnt += (c > 0u) ? 1u : 0u; mine = (j == x) ? c : mine; }
        if (sum == G) break;
        __builtin_amdgcn_s_sleep(1);
        if ((++sp & 255u) == 0u) { if (xb_ld(&bar[XB_TMO])) break; if (sp > XB_SPIN_CAP) { atomicAdd(&bar[XB_TMO], 1u); break; } }
    }
    nloc = mine > 0u ? mine : 1u; nx = cnt > 0u ? cnt : 1u;
}
__device__ __forceinline__ void xcd_barrier(const XcdBarrier& b, unsigned& nloc_s, unsigned& nx_s) {
    asm volatile("s_waitcnt vmcnt(0)" ::: "memory");
    __syncthreads();
    if (threadIdx.x == 0) {
        unsigned* bar = b.bar;
        __builtin_amdgcn_s_waitcnt(0);
        unsigned nloc = nloc_s, nx = nx_s;
        if (nloc == 0u) { xcd_barrier_complete(bar, b.x, nloc, nx); nloc_s = nloc; nx_s = nx; }
        const unsigned old = xb_add(&bar[XB_XSUB(b.x)], 1u);
        const unsigned gen = old / nloc;
        if (old + 1u == (gen + 1u) * nloc) {
            __builtin_amdgcn_fence(__ATOMIC_RELEASE, "agent");
            asm volatile("s_waitcnt vmcnt(0)" ::: "memory");
            const unsigned og = xb_add(&bar[XB_TOP], 1u);
            const unsigned tg = og / nx;
            if (og + 1u == (tg + 1u) * nx) xb_add(&bar[XB_TOPGEN], 1u);
            else XB_SPIN(xb_ld(&bar[XB_TOPGEN]) == tg, bar);
            __builtin_amdgcn_fence(__ATOMIC_ACQUIRE, "agent");
            xb_add(&bar[XB_XGEN(b.x)], 1u);
            asm volatile("s_waitcnt vmcnt(0)" ::: "memory");
        } else {
            XB_SPIN(xb_ld(&bar[XB_XGEN(b.x)]) == gen, bar);
            __builtin_amdgcn_fence(__ATOMIC_ACQUIRE, "agent");
            asm volatile("s_waitcnt vmcnt(0)" ::: "memory");
        }
    }
    __syncthreads();
}

__device__ __forceinline__ void sub_barrier(unsigned* ctr, unsigned target) {
    asm volatile("s_waitcnt vmcnt(0)" ::: "memory");
    __syncthreads();
    if (threadIdx.x == 0) {
        __builtin_amdgcn_s_waitcnt(0);
        __builtin_amdgcn_fence(__ATOMIC_RELEASE, "agent");
        asm volatile("s_waitcnt vmcnt(0)" ::: "memory");
        (void)xb_add(ctr, 1u);
        unsigned sp = 0;
        while (xb_ld(ctr) < target) { __builtin_amdgcn_s_sleep(2); if (++sp > (1u << 24)) break; }
        __builtin_amdgcn_fence(__ATOMIC_ACQUIRE, "agent");
        asm volatile("s_waitcnt vmcnt(0)" ::: "memory");
    }
    __syncthreads();
}

#ifndef PHASE_MASK
#define PHASE_MASK 0xFFFF
#endif
#define PH(k) if ((PHASE_MASK >> (k)) & 1)
__global__ void __launch_bounds__(512, 2) fwd_megakernel(Args args) {
    extern __shared__ __attribute__((aligned(16))) unsigned char lds_raw[];
    LAS unsigned char* lds = (LAS unsigned char*)lds_raw;
    cg::grid_group grid = cg::this_grid();
    const int tid = threadIdx.x, lane = tid & 63, wave = __builtin_amdgcn_readfirstlane(tid >> 6);
    const int G = gridDim.x, wg = blockIdx.x, gw = wg * 8 + wave, NGW = G * 8;
    unsigned char* ws = args.ws;
    const XcdBarrier xbar = xcd_barrier_post((unsigned*)(ws + WS_CTL)); unsigned xb_nloc = 0u, xb_nx = 0u;
    const float* x_in = args.in[0]; float* out = args.out;
    bf16_t* WinT = (bf16_t*)(ws + WS_WIN); bf16_t* WoaT = (bf16_t*)(ws + WS_WOA); bf16_t* WolT = (bf16_t*)(ws + WS_WOL); bf16_t* WoutT = (bf16_t*)(ws + WS_WOUT);
    bf16_t* WupT = (bf16_t*)(ws + WS_WUP); bf16_t* WdnT = (bf16_t*)(ws + WS_WDN); bf16_t* WGT = (bf16_t*)(ws + WS_WG);
    float* biasT = (float*)(ws + WS_MISC); float* ss = (float*)(ws + WS_SS); unsigned* queue = (unsigned*)(ws + WS_CTL + 32768); unsigned* xcflags = (unsigned*)(ws + WS_CTL + 40960);
    bf16_t* xb = (bf16_t*)(ws + WS_XB); bf16_t* P = (bf16_t*)(ws + WS_P);

#ifdef PROBE_A
    unsigned long long tprev = __builtin_amdgcn_s_memrealtime(); float pa = 0.f, pb = 0.f;
#define STAMP(k) do { const unsigned long long tn = __builtin_amdgcn_s_memrealtime(); const float dt = (float)(tn - tprev) * 0.01f; tprev = tn; if ((PROBE_A >> (k)) & 1) pa += dt; if ((PROBE_B >> (k)) & 1) pb += dt; } while (0)
#else
#define STAMP(k) do {} while (0)
#endif
    PH(0) {
        LAS float* scr = (LAS float*)(lds + wave * 16384);
#define CONVERT_LAYER(lw, gwv, ngwv) do { const int l_ = (lw); \
            constexpr int I_IN = (D / 64) * (NIN / 32), I_DD = (D / 64) * (D / 32), I_UP = (D / 64) * (FF / 32), I_DN = (FF / 64) * (D / 32), I_G = 2 * 16 * 8; \
            _Pragma("unroll 1") for (int it = (gwv); it < I_IN + 3 * I_DD + I_UP + I_DN + I_G; it += (ngwv)) { \
                int r_ = it; const float* W_; bf16_t* WT_; const float* gn_ = nullptr; int K_ = D, N_ = D; \
                if (r_ < I_IN) { W_ = args.in[1] + (size_t)l_ * D * NIN; WT_ = WinT + (size_t)l_ * NIN * D; gn_ = args.in[14] + l_ * D; N_ = NIN; } \
                else if ((r_ -= I_IN) < 3 * I_DD) { const int m_ = r_ / I_DD; r_ -= m_ * I_DD; W_ = args.in[2 + m_] + (size_t)l_ * D * D; WT_ = (m_ == 0 ? WoaT : (m_ == 1 ? WolT : WoutT)) + (size_t)l_ * D * D; } \
                else if ((r_ -= 3 * I_DD) < I_UP) { W_ = args.in[16] + (size_t)l_ * D * FF; WT_ = WupT + (size_t)l_ * FF * D; gn_ = args.in[15] + l_ * D; N_ = FF; } \
                else if ((r_ -= I_UP) < I_DN) { W_ = args.in[17] + (size_t)l_ * FF * D; WT_ = WdnT + (size_t)l_ * D * FF; K_ = FF; } \
                else { r_ -= I_DN; const int g_ = r_ >> 7, mat_ = l_ * 16 + ((r_ >> 3) & 15); r_ &= 7; K_ = 128; N_ = 128; \
                    W_ = args.in[g_ ? 11 : 9] + (size_t)mat_ * 16384; WT_ = WGT + (size_t)((mat_ >> 3) * 16 + g_ * 8 + (mat_ & 7)) * 16384; } \
                transpose_item(W_, K_, N_, WT_, gn_, scr, r_, lane); } } while (0)
        CONVERT_LAYER(0, gw, NGW);
        for (int m0 = 2 * gw; m0 < M; m0 += 2 * NGW) {
            f32x4 v[2][4]; float sq[2];
#pragma unroll
            for (int r2 = 0; r2 < 2; ++r2) { const f32x4* xr = (const f32x4*)(x_in + (size_t)(m0 + r2) * D) + lane;
#pragma unroll
                for (int j = 0; j < 4; ++j) v[r2][j] = xr[64 * j]; }
#pragma unroll
            for (int r2 = 0; r2 < 2; ++r2) { float s = 0.f;
#pragma unroll
                for (int j = 0; j < 4; ++j) s += (v[r2][j].x * v[r2][j].x + v[r2][j].y * v[r2][j].y) + (v[r2][j].z * v[r2][j].z + v[r2][j].w * v[r2][j].w);
                sq[r2] = wave_sum(s);
                u32x2* o8 = (u32x2*)(xb + (size_t)(m0 + r2) * D) + lane;
#pragma unroll
                for (int j = 0; j < 4; ++j) { u32x2 w; w.x = pk2(v[r2][j].x, v[r2][j].y); w.y = pk2(v[r2][j].z, v[r2][j].w); o8[64 * j] = w; }
                if (lane < 16) ss[(size_t)(m0 + r2) * 16 + lane] = lane == 0 ? sq[r2] : 0.f; }
        }
        if (wg == 0 && tid < DEPTH) queue[tid * 64] = 0u;
        for (int idx = wg * 512 + tid; idx < 8 * 512; idx += G * 512) { const int hh = idx >> 9, rel = (idx & 511) - 256;
            biasT[idx] = (rel < -128 || rel > 128) ? -1.0e30f : args.in[6][t5_bucket(rel) * 8 + hh] * LOG2E; }
    }
    __syncthreads();
    grid.sync(); STAMP(0);

#pragma unroll 1
    for (int l = 0; l < DEPTH; ++l) {
        PH(1) { pg8::Gemm g{xb, WinT + (size_t)l * NIN * D, M, NIN, D}; pg8::StaticOrder S; S.init(M, NIN, G, wg); pg8::EpiIn E{P, ss, 0}; pg8::gemm_phase(lds, g, S, E); }
        xcd_barrier(xbar, xb_nloc, xb_nx); STAMP(1);
        const bf16_t* WGl = WGT + (size_t)l * 32 * 16384;
        const int GH = G >> 1;
        if (wg < GH) {
            PH(2) { for (int task = wg; task < LRU_TASKS; task += GH) lru_stream(lds, P + P_XR, P + P_GR, (bf16_t*)out, (bf16_t*)out + (size_t)M * 1024, args.in[7] + l * 4096, args.in[8] + l * 1024, WGl, args.in[10] + l * 2048, args.in[12] + l * 2048, args.in[13] + l * 2048, task, xcflags, (unsigned)(l + 1)); }
        } else {
            PH(2) xc_produce(P + P_XR, (bf16_t*)out + (size_t)M * 1024, args.in[7] + l * 4096, args.in[8] + l * 1024, xcflags, (unsigned)(l + 1), wg - GH, G - GH);
            PH(3) attn_phase(lds, P + P_Q, P + P_KV, biasT, args.in[5] + l * 8, queue + l * 64);
            PH(0) if (l + 1 < DEPTH) { int tidc = threadIdx.x; asm volatile("" : "+v"(tidc)); const int lane = tidc & 63, wv = __builtin_amdgcn_readfirstlane(tidc >> 6); LAS float* scr = (LAS float*)(lds + wv * 16384);
                CONVERT_LAYER(l + 1, (wg - GH) * 8 + wv, (G - GH) * 8); }
        }
        STAMP(2);
        xcd_barrier(xbar, xb_nloc, xb_nx); STAMP(3);
        PH(6) { pg8::Gemm g{P + P_Q, WoaT + (size_t)l * D * D, M, D, D}; pg8::StaticOrder S; S.init(M, D, G, wg); pg8::EpiGate<0> E{P + P_GA, P + P_GB, nullptr}; pg8::gemm_phase(lds, g, S, E); }
        STAMP(6);
        PH(7) { pg8::Gemm g{P + P_GR, WolT + (size_t)l * D * D, M, D, D}; pg8::StaticOrder S; S.init(M, D, G, wg); pg8::EpiGate<1> E{P + P_GA, P + P_GB, nullptr}; pg8::gemm_phase(lds, g, S, E); }
        xcd_barrier(xbar, xb_nloc, xb_nx); STAMP(7);
        PH(8) { pg8::Gemm g{P + P_GA, WoutT + (size_t)l * D * D, M, D, D}; pg8::StaticOrder S; S.init(M, D, G, wg); pg8::EpiRes E{xb, ss}; pg8::gemm_phase(lds, g, S, E); }
        xcd_barrier(xbar, xb_nloc, xb_nx); STAMP(8);
        PH(9) { pg8::Gemm g{xb, WupT + (size_t)l * FF * D, M, FF, D}; pg8::StaticOrder S; S.init(M, FF, G, wg); pg8::EpiUp E{P, ss}; pg8::gemm_phase(lds, g, S, E); }
        xcd_barrier(xbar, xb_nloc, xb_nx); STAMP(9);
        PH(10) { pg8::Gemm g{P, WdnT + (size_t)l * D * FF, M, D, FF}; pg8::StaticOrder S; S.init(M, D, G, wg); pg8::EpiRes E{xb, ss}; pg8::gemm_phase(lds, g, S, E); }
        xcd_barrier(xbar, xb_nloc, xb_nx); STAMP(10);
    }
#ifdef PROBE_A
    if (wg == 0 && tid == 0) { biasT[8192] = exp2f(rintf(log2f(pa) * 3.f) * (1.f / 3.f)); biasT[8193] = exp2f(rintf(log2f(pb) * 3.f) * (1.f / 3.f)) * 0.001f; }
    __threadfence(); xcd_barrier(xbar, xb_nloc, xb_nx);
    const float probeA = biasT[8192], probeB = biasT[8193];
#endif
    PH(11) {
        int tidf = threadIdx.x; asm volatile("" : "+v"(tidf));
        const int lane = tidf & 63, gw = wg * 8 + __builtin_amdgcn_readfirstlane(tidf >> 6);
        const float* gfin = args.in[18];
        f32x4 gv[4];
#pragma unroll
        for (int j = 0; j < 4; ++j) gv[j] = ((const f32x4*)gfin)[lane + 64 * j];
        for (int m0 = 2 * gw; m0 < M; m0 += 2 * NGW) {
            u32x2 t[2][4];
#pragma unroll
            for (int r2 = 0; r2 < 2; ++r2) { const u32x2* xi = (const u32x2*)(xb + (size_t)(m0 + r2) * D) + lane;
#pragma unroll
                for (int j = 0; j < 4; ++j) t[r2][j] = xi[64 * j]; }
#pragma unroll
            for (int r2 = 0; r2 < 2; ++r2) { f32x4 v[4]; float s = 0.f;
#pragma unroll
                for (int j = 0; j < 4; ++j) { v[j] = (f32x4){bflo(t[r2][j].x), bfhi(t[r2][j].x), bflo(t[r2][j].y), bfhi(t[r2][j].y)}; s += (v[j].x * v[j].x + v[j].y * v[j].y) + (v[j].z * v[j].z + v[j].w * v[j].w); }
                s = wave_sum(s);
                const float rs = 1.f / sqrtf(s * (1.f / 1024.f) + 1e-6f);
                f32x4* xr = (f32x4*)(out + (size_t)(m0 + r2) * D) + lane;
#pragma unroll
                for (int j = 0; j < 4; ++j) {
#ifdef PROBE_A
                    f32x4 o = v[j] * rs * gv[j] + probeB; if (m0 + r2 == 0 && lane == 0 && j == 0) o.x += probeA; xr[64 * j] = o;
#else
                    xr[64 * j] = v[j] * rs * gv[j];
#endif
                } }
        }
    }
}

extern "C" void kernel_launch(void* const* d_in, const int* in_sizes, int n_in, void* d_out, int out_size, void* d_ws, size_t ws_size, hipStream_t stream) {
    static int grid = 0;
    if (grid == 0) {
        if (n_in != 19 || out_size != M * D || ws_size < WS_END) { fprintf(stderr, "kernel_launch: unexpected problem: n_in %d out %d ws %zu (need %zu)\n", n_in, out_size, ws_size, (size_t)WS_END); grid = -1; return; }
        int dev = 0, cus = 0, per_cu = 0;
        hipGetDevice(&dev);
        hipDeviceGetAttribute(&cus, hipDeviceAttributeMultiprocessorCount, dev);
        if (hipFuncSetAttribute((const void*)fwd_megakernel, hipFuncAttributeMaxDynamicSharedMemorySize, LDS_BYTES) != hipSuccess) { fprintf(stderr, "kernel_launch: hipFuncSetAttribute failed\n"); grid = -1; return; }
        if (hipOccupancyMaxActiveBlocksPerMultiprocessor(&per_cu, (const void*)fwd_megakernel, 512, LDS_BYTES) != hipSuccess || per_cu < 1) { fprintf(stderr, "kernel_launch: occupancy query gave %d\n", per_cu); per_cu = 1; }
        (void)hipGetLastError();
        grid = cus * per_cu;
    }
    if (grid < 0) return;
    if (hipMemsetAsync((char*)d_ws + WS_CTL, 0, CTL_BYTES, stream) != hipSuccess) { fprintf(stderr, "kernel_launch: memset failed\n"); return; }
    Args a{};
    for (int i = 0; i < 19; ++i) a.in[i] = (const float*)d_in[i];
    a.out = (float*)d_out; a.ws = (unsigned char*)d_ws;
    void* kargs[] = {&a};
    hipError_t e = hipLaunchCooperativeKernel((const void*)fwd_megakernel, dim3(grid), dim3(512), kargs, LDS_BYTES, stream);
    if (e != hipSuccess) fprintf(stderr, "kernel_launch: cooperative launch failed: %s (grid %d)\n", hipGetErrorString(e), grid);
}
```

```cpp
#include <hip/hip_runtime.h>
#include <hip/hip_cooperative_groups.h>
#include <cstdio>
#include <cstdint>
namespace cg = cooperative_groups;

#define LAS __attribute__((address_space(3)))
typedef unsigned short bf16_t;
typedef short bf16x8 __attribute__((ext_vector_type(8)));
typedef short s16x4 __attribute__((ext_vector_type(4)));
typedef float f32x2 __attribute__((ext_vector_type(2)));
typedef float f32x4 __attribute__((ext_vector_type(4)));
typedef float f32x16 __attribute__((ext_vector_type(16)));
typedef unsigned u32x2 __attribute__((ext_vector_type(2)));
typedef unsigned u32x4 __attribute__((ext_vector_type(4)));
typedef __bf16 bf16x2n __attribute__((ext_vector_type(2)));

constexpr int BATCH = 8, SEQ = 8192, D = 1024, DEPTH = 4, NIN = 5632, FF = 4096;
constexpr int M = BATCH * SEQ;
constexpr float LOG2E = 1.4426950408889634f;
constexpr float QSCALE = 0.08838834764831845f * LOG2E;

constexpr size_t MiB = 1u << 20;
constexpr size_t WS_WIN = 0, WS_WOA = 44 * MiB, WS_WOL = 52 * MiB, WS_WOUT = 60 * MiB, WS_WUP = 68 * MiB, WS_WDN = 100 * MiB, WS_WG = 132 * MiB;
constexpr size_t WS_MISC = 136 * MiB, WS_SS = 137 * MiB, WS_AGG = 141 * MiB, WS_CARRY = 157 * MiB, WS_XB = 165 * MiB, WS_P = 293 * MiB;
constexpr size_t P_Q = 0, P_KV = (size_t)M * 1024, P_XR = P_KV + (size_t)M * 512, P_GR = P_XR + (size_t)M * 1024, P_GA = P_GR + (size_t)M * 1024, P_GB = P_GA + (size_t)M * 1024;
constexpr size_t WS_END = WS_P + (P_GB + (size_t)M * 1024) * 2;
static_assert(WS_END == 997 * MiB, "ws map");
constexpr int LDS_BYTES = 163840;
constexpr int LDS_SS = 131072;
constexpr size_t WS_CTL = WS_MISC + 131072, CTL_BYTES = 65536;

__device__ __forceinline__ unsigned pk2(float a, float b) { f32x2 v = {a, b}; bf16x2n r = __builtin_convertvector(v, bf16x2n); return __builtin_bit_cast(unsigned, r); }
__device__ __forceinline__ float bflo(unsigned u) { return __builtin_bit_cast(float, u << 16); }
__device__ __forceinline__ float bfhi(unsigned u) { return __builtin_bit_cast(float, u & 0xffff0000u); }
__device__ __forceinline__ float sigmoidf_(float x) { return __builtin_amdgcn_rcpf(1.f + __expf(-x)); }

namespace pg8 {
constexpr int BM = 256, BK = 64, HALF = 128, HTB = HALF * BK * 2, STAGE_BYTES = 8 * HTB, NXCD = 8, WGM = 8;
__host__ __device__ __forceinline__ int lds_byte(int r, int c) { const int st = (r >> 4) * 2 + (c >> 5), rr = r & 15, cc = c & 31, ob = rr * 64 + cc * 2; return st * 1024 + (ob ^ (((ob >> 9) & 1) << 5)); }
__host__ __device__ __forceinline__ void stage_rc(int b, int& R, int& C) { const int st = b / 1024, sb = b % 1024, swz = sb ^ (((sb >> 9) & 1) << 5); R = (st >> 1) * 16 + swz / 64; C = (st & 1) * 32 + (swz % 64) / 2; }
__host__ __device__ __forceinline__ int perm32(int rho) { const int n = rho >> 4, i = rho & 15; return 8 * (i >> 2) + 4 * n + (i & 3); }

struct Unit { int pm, pn; };
struct Gemm { const bf16_t* A; const bf16_t* Bt; int M, N, K; };

struct StaticOrder {
    int nM, nN, nwg, G, c;
    __host__ __device__ void init(int M_, int N_, int G_, int c_) { nM = M_ / BM; nN = N_ / BM; nwg = nM * nN; G = G_; c = c_; }
    __host__ __device__ bool next(int i, Unit& u) const {
        const long L = (long)i * G + c; if (L >= nwg) return false;
        int wgid = (int)L; { const int q = nwg / NXCD, r = nwg % NXCD, xcd = wgid % NXCD, off = wgid / NXCD; wgid = (xcd < r ? xcd * (q + 1) : r * (q + 1) + (xcd - r) * q) + off; }
        const int nig = WGM * nN, gid = wgid / nig, fm = gid * WGM, gsz = (nM - fm) < WGM ? (nM - fm) : WGM;
        u.pm = fm + ((wgid % nig) % gsz); u.pn = (wgid % nig) / gsz; return true;
    }
};

__device__ __forceinline__ float row_rstd(const float* ss, int row) {
    const f32x4* p = (const f32x4*)(ss + (size_t)row * 16);
    const f32x4 a = p[0], b = p[1], c = p[2], d = p[3];
    const float s = (((a.x + a.y) + (a.z + a.w)) + ((b.x + b.y) + (b.z + b.w))) + (((c.x + c.y) + (c.z + c.w)) + ((d.x + d.y) + (d.z + d.w)));
    return __builtin_amdgcn_rsqf(s * (1.f / 1024.f) + 1e-6f);
}

__device__ __forceinline__ float row_rstd_lds(const LAS unsigned char* img, int rl) {
    const LAS f32x4* p = (const LAS f32x4*)(img + rl * 64);
    const f32x4 a = p[0], b = p[1], c = p[2], d = p[3];
    const float s = (((a.x + a.y) + (a.z + a.w)) + ((b.x + b.y) + (b.z + b.w))) + (((c.x + c.y) + (c.z + c.w)) + ((d.x + d.y) + (d.z + d.w)));
    return __builtin_amdgcn_rsqf(s * (1.f / 1024.f) + 1e-6f);
}
struct EpiIn {
    static constexpr bool PERM = true, RSTD = true;
    bf16_t* P; const float* ss; int pn_off;
    __device__ __forceinline__ void operator()(const f32x4 (&acc)[2][2][4][2], const Unit& u, int wr, int wc, int fr, int fq, const LAS unsigned char* img) const {
        const int pn = u.pn + pn_off; bf16_t* base; int ld; float sc = 1.f;
        if (pn < 4) { base = P + P_Q + pn * 256; ld = 1024; sc = QSCALE; }
        else if (pn < 6) { base = P + P_KV + (pn - 4) * 256; ld = 512; }
        else { const int t = (pn - 6) >> 2, c = (pn - 6) & 3; base = P + P_XR + (size_t)t * ((size_t)M * 1024) + c * 256; ld = 1024; }
        const bool isgate = (pn >= 10 && pn < 14);
        const int row0 = u.pm * BM + wr * 64 + fr, col0 = wc * 32 + 8 * fq;
#pragma unroll
        for (int ai = 0; ai < 2; ++ai)
#pragma unroll
            for (int m = 0; m < 4; ++m) { const int row = row0 + ai * HALF + m * 16; const float rs = row_rstd_lds(img, wr * 64 + fr + ai * HALF + m * 16) * sc; bf16_t* rowp = base + (size_t)row * ld + col0;
#pragma unroll
                for (int bj = 0; bj < 2; ++bj) { f32x4 v0 = acc[ai][bj][m][0] * rs, v1 = acc[ai][bj][m][1] * rs;
                    if (isgate) {
#pragma unroll
                        for (int j = 0; j < 4; ++j) { const float a = v0[j], b = v1[j];
                            v0[j] = a * __builtin_amdgcn_rcpf(1.f + __builtin_amdgcn_exp2f(-1.5957691216057308f * LOG2E * (a + 0.044715f * a * a * a)));
                            v1[j] = b * __builtin_amdgcn_rcpf(1.f + __builtin_amdgcn_exp2f(-1.5957691216057308f * LOG2E * (b + 0.044715f * b * b * b))); } }
                    u32x4 w; w.x = pk2(v0[0], v0[1]); w.y = pk2(v0[2], v0[3]); w.z = pk2(v1[0], v1[1]); w.w = pk2(v1[2], v1[3]);
                    *(u32x4*)(rowp + bj * HALF) = w; } }
    }
};
struct EpiUp {
    static constexpr bool PERM = true, RSTD = true;
    bf16_t* U; const float* ss;
    __device__ __forceinline__ void operator()(const f32x4 (&acc)[2][2][4][2], const Unit& u, int wr, int wc, int fr, int fq, const LAS unsigned char* img) const {
        const int row0 = u.pm * BM + wr * 64 + fr, col0 = u.pn * BM + wc * 32 + 8 * fq;
#pragma unroll
        for (int ai = 0; ai < 2; ++ai)
#pragma unroll
            for (int m = 0; m < 4; ++m) { const int row = row0 + ai * HALF + m * 16; const float rs = row_rstd_lds(img, wr * 64 + fr + ai * HALF + m * 16); bf16_t* rowp = U + (size_t)row * FF + col0;
#pragma unroll
                for (int bj = 0; bj < 2; ++bj) { f32x4 v0 = acc[ai][bj][m][0] * rs, v1 = acc[ai][bj][m][1] * rs;
#pragma unroll
                    for (int j = 0; j < 4; ++j) { const float a = fmaxf(v0[j], 0.f), b = fmaxf(v1[j], 0.f); v0[j] = a * a; v1[j] = b * b; }
                    u32x4 w; w.x = pk2(v0[0], v0[1]); w.y = pk2(v0[2], v0[3]); w.z = pk2(v1[0], v1[1]); w.w = pk2(v1[2], v1[3]);
                    *(u32x4*)(rowp + bj * HALF) = w; } }
    }
};
template <int STAGE> struct EpiGate {
    static constexpr bool PERM = true, RSTD = false;
    bf16_t* GA; const bf16_t* GB; const float* ss;
    __device__ __forceinline__ void operator()(const f32x4 (&acc)[2][2][4][2], const Unit& u, int wr, int wc, int fr, int fq, const LAS unsigned char* img) const {
        const int row0 = u.pm * BM + wr * 64 + fr, col0 = u.pn * BM + wc * 32 + 8 * fq;
#pragma unroll
        for (int ai = 0; ai < 2; ++ai)
#pragma unroll
            for (int m = 0; m < 4; ++m) { const size_t off = (size_t)(row0 + ai * HALF + m * 16) * 1024 + col0;
#pragma unroll
                for (int bj = 0; bj < 2; ++bj) {
                    const u32x4 g = *(const u32x4*)((STAGE == 0 ? (const bf16_t*)GA : GB) + off + bj * HALF);
                    float s[8] = {bflo(g.x), bfhi(g.x), bflo(g.y), bfhi(g.y), bflo(g.z), bfhi(g.z), bflo(g.w), bfhi(g.w)};
                    float o[8];
#pragma unroll
                    for (int j = 0; j < 8; ++j) o[j] = sigmoidf_(s[j]) * acc[ai][bj][m][j >> 2][j & 3];
                    if (STAGE == 1) { const u32x4 t = *(const u32x4*)(GA + off + bj * HALF);
                        o[0] += bflo(t.x); o[1] += bfhi(t.x); o[2] += bflo(t.y); o[3] += bfhi(t.y); o[4] += bflo(t.z); o[5] += bfhi(t.z); o[6] += bflo(t.w); o[7] += bfhi(t.w); }
                    u32x4 w; w.x = pk2(o[0], o[1]); w.y = pk2(o[2], o[3]); w.z = pk2(o[4], o[5]); w.w = pk2(o[6], o[7]);
                    *(u32x4*)(GA + off + bj * HALF) = w; } }
    }
};
struct EpiRes {
    static constexpr bool PERM = true, RSTD = false;
    bf16_t* xb; float* ss;
    __device__ __forceinline__ void operator()(const f32x4 (&acc)[2][2][4][2], const Unit& u, int wr, int wc, int fr, int fq, const LAS unsigned char* img) const {
        const int row0 = u.pm * BM + wr * 64 + fr, col0 = u.pn * BM + wc * 32 + 8 * fq;
#pragma unroll
        for (int ai = 0; ai < 2; ++ai)
#pragma unroll
            for (int m = 0; m < 4; ++m) { const int row = row0 + ai * HALF + m * 16; const size_t off = (size_t)row * 1024 + col0; float sq = 0.f;
#pragma unroll
                for (int bj = 0; bj < 2; ++bj) { const u32x4 t = *(const u32x4*)(xb + off + bj * HALF);
                    float o[8] = {bflo(t.x), bfhi(t.x), bflo(t.y), bfhi(t.y), bflo(t.z), bfhi(t.z), bflo(t.w), bfhi(t.w)};
#pragma unroll
                    for (int j = 0; j < 8; ++j) { o[j] += acc[ai][bj][m][j >> 2][j & 3]; sq += o[j] * o[j]; }
                    u32x4 w; w.x = pk2(o[0], o[1]); w.y = pk2(o[2], o[3]); w.z = pk2(o[4], o[5]); w.w = pk2(o[6], o[7]);
                    *(u32x4*)(xb + off + bj * HALF) = w; }
                sq += __shfl_xor(sq, 16); sq += __shfl_xor(sq, 32);
                if (fq == 0) ss[(size_t)row * 16 + u.pn * 4 + wc] = sq; }
    }
};

template <class Epi>
__device__ __forceinline__ void gemm_phase(LAS unsigned char* lds, const Gemm g, const StaticOrder& S, const Epi& E) {
    int tid = threadIdx.x; asm volatile("" : "+v"(tid));
    const int wid = __builtin_amdgcn_readfirstlane(tid >> 6), lane = tid & 63, wr = wid >> 2, wc = wid & 3, fr = lane & 15, fq = lane >> 4;
    const int K = g.K, nt = K / BK;
    unsigned voffA[2], voffB[2];
#pragma unroll
    for (int i = 0; i < 2; ++i) { int R, C; stage_rc(tid * 16 + i * 8192, R, C); const int Rb = Epi::PERM ? ((R & ~31) + perm32(R & 31)) : R;
        voffA[i] = (unsigned)(R * K + C) * 2u; voffB[i] = (unsigned)(Rb * K + C) * 2u; }
    const size_t kstep = (size_t)(BK * 2);
    const size_t hstep = (size_t)HALF * K * 2;
    const size_t tstep = 2 * hstep;
    const unsigned ldsw = (unsigned)wid * 1024u;
    const int aoff = lds_byte(wr * 64 + fr, fq * 8), boff = lds_byte(wc * 32 + fr, fq * 8);
#define PG8_SA(b, h) (((b) * 2 + (h)) * HTB)
#define PG8_SB(b, h) ((4 + (b) * 2 + (h)) * HTB)
#define PG8_STAGE(bufoff, gbase, voff) do { _Pragma("unroll") for (int _i = 0; _i < 2; ++_i) \
        __builtin_amdgcn_global_load_lds((const unsigned*)((const char*)(gbase) + (voff)[_i]), (LAS unsigned*)(lds + (bufoff) + ldsw + _i * 8192), 16, 0, 0); } while (0)
#define PG8_LDA(dst, b, h) do { _Pragma("unroll") for (int m = 0; m < 4; ++m) _Pragma("unroll") for (int k = 0; k < 2; ++k) dst[m][k] = *(const LAS bf16x8*)(lds + PG8_SA(b, h) + aoff + m * 2048 + k * 1024); } while (0)
#define PG8_LDB(dst, b, h) do { _Pragma("unroll") for (int n = 0; n < 2; ++n) _Pragma("unroll") for (int k = 0; k < 2; ++k) dst[n][k] = *(const LAS bf16x8*)(lds + PG8_SB(b, h) + boff + n * 2048 + k * 1024); } while (0)
#define PG8_MMA(ai, bj, At, Bt) do { __builtin_amdgcn_s_setprio(1); _Pragma("unroll") for (int m = 0; m < 4; ++m) _Pragma("unroll") for (int n = 0; n < 2; ++n) _Pragma("unroll") for (int k = 0; k < 2; ++k) \
        acc[ai][bj][m][n] = __builtin_amdgcn_mfma_f32_16x16x32_bf16(Bt[n][k], At[m][k], acc[ai][bj][m][n], 0, 0, 0); __builtin_amdgcn_s_setprio(0); } while (0)
#define PG8_WAIT_V(n) asm volatile("s_waitcnt vmcnt(" #n ")" ::: "memory")
#define PG8_WAIT_L(n) asm volatile("s_waitcnt lgkmcnt(" #n ")" ::: "memory")
#define PG8_BAR __builtin_amdgcn_s_barrier()
#define PG8_SCHED __builtin_amdgcn_sched_barrier(0)
    Unit cur, nxt; int ui = 0;
    if (!S.next(0, cur)) return;
    f32x4 acc[2][2][4][2];
#pragma unroll
    for (int a = 0; a < 2; ++a)
#pragma unroll
        for (int b = 0; b < 2; ++b)
#pragma unroll
            for (int m = 0; m < 4; ++m)
#pragma unroll
                for (int n = 0; n < 2; ++n) acc[a][b][m][n] = (f32x4){0.f, 0.f, 0.f, 0.f};
    bf16x8 At[4][2], B0[2][2], B1[2][2];
    const char* cA = (const char*)g.A + (size_t)cur.pm * tstep; const char* cB = (const char*)g.Bt + (size_t)cur.pn * tstep;
    PG8_STAGE(PG8_SB(0, 0), cB, voffB); PG8_STAGE(PG8_SB(0, 1), cB + hstep, voffB); PG8_STAGE(PG8_SA(0, 0), cA, voffA); PG8_STAGE(PG8_SA(0, 1), cA + hstep, voffA);
    if (wr == 1) PG8_BAR;
    PG8_WAIT_V(2); PG8_BAR;
    PG8_STAGE(PG8_SB(1, 0), cB + kstep, voffB); PG8_STAGE(PG8_SA(1, 0), cA + kstep, voffA); PG8_STAGE(PG8_SB(1, 1), cB + hstep + kstep, voffB);
    PG8_WAIT_V(6); PG8_BAR;
    for (;;) {
        const bool has_next = S.next(ui + 1, nxt);
        const char* nA = has_next ? (const char*)g.A + (size_t)nxt.pm * tstep : cA; const char* nB = has_next ? (const char*)g.Bt + (size_t)nxt.pn * tstep : cB;
        LAS unsigned char* img = lds + LDS_SS + (ui & 1) * 16384;
        if constexpr (Epi::RSTD) {
#pragma unroll
            for (int i = 0; i < 2; ++i) __builtin_amdgcn_global_load_lds((const unsigned*)(E.ss + ((size_t)cur.pm * BM) * 16 + (size_t)(tid + 512 * i) * 4), (LAS unsigned*)(img + wid * 1024 + i * 8192), 16, 0, 0);
        }
        for (int t = 0; t < nt; t += 2) {
            const bool last = (t == nt - 2);
            const char* a1 = cA + (size_t)(t + 1) * kstep;
            const char* a2 = last ? nA : cA + (size_t)(t + 2) * kstep; const char* b2 = last ? nB : cB + (size_t)(t + 2) * kstep;
            const char* a3 = a2 + kstep; const char* b3 = b2 + kstep;
            PG8_LDB(B0, 0, 0); PG8_LDB(B1, 0, 1); PG8_SCHED; PG8_LDA(At, 0, 0); PG8_STAGE(PG8_SA(1, 1), a1 + hstep, voffA);
            PG8_WAIT_V(8); PG8_WAIT_L(0); PG8_BAR; PG8_MMA(0, 0, At, B0); PG8_MMA(0, 1, At, B1); PG8_BAR; PG8_SCHED;
            PG8_LDA(At, 0, 1); PG8_STAGE(PG8_SB(0, 0), b2, voffB); PG8_STAGE(PG8_SB(0, 1), b2 + hstep, voffB); PG8_STAGE(PG8_SA(0, 0), a2, voffA);
            PG8_WAIT_V(8); PG8_WAIT_L(0); PG8_BAR; PG8_MMA(1, 0, At, B0); PG8_MMA(1, 1, At, B1); PG8_BAR; PG8_SCHED;
            PG8_LDB(B0, 1, 0); PG8_LDB(B1, 1, 1); PG8_SCHED; PG8_LDA(At, 1, 0); PG8_STAGE(PG8_SA(0, 1), a2 + hstep, voffA);
            PG8_WAIT_V(8); PG8_WAIT_L(0); PG8_BAR; PG8_MMA(0, 0, At, B0); PG8_MMA(0, 1, At, B1); PG8_BAR; PG8_SCHED;
            PG8_LDA(At, 1, 1); PG8_STAGE(PG8_SB(1, 0), b3, voffB); PG8_STAGE(PG8_SB(1, 1), b3 + hstep, voffB); PG8_STAGE(PG8_SA(1, 0), a3, voffA);
            PG8_WAIT_V(8); PG8_WAIT_L(0); PG8_BAR; PG8_MMA(1, 0, At, B0); PG8_MMA(1, 1, At, B1); PG8_BAR; PG8_SCHED;
        }
        if (wr == 0) PG8_BAR;
        E(acc, cur, wr, wc, fr, fq, img);
        if (!has_next) break;
#pragma unroll
        for (int a = 0; a < 2; ++a)
#pragma unroll
            for (int b = 0; b < 2; ++b)
#pragma unroll
                for (int m = 0; m < 4; ++m)
#pragma unroll
                    for (int n = 0; n < 2; ++n) acc[a][b][m][n] = (f32x4){0.f, 0.f, 0.f, 0.f};
        cur = nxt; cA = nA; cB = nB; ++ui;
        if (wr == 1) PG8_BAR;
    }
    PG8_WAIT_V(0);
    PG8_BAR;
#undef PG8_SA
#undef PG8_SB
#undef PG8_STAGE
#undef PG8_LDA
#undef PG8_LDB
#undef PG8_MMA
#undef PG8_WAIT_V
#undef PG8_WAIT_L
#undef PG8_BAR
#undef PG8_SCHED
}
}

struct Args { const float* in[19]; float* out; unsigned char* ws; };

__device__ __forceinline__ float wave_sum(float v) {
#pragma unroll
    for (int o = 1; o < 64; o <<= 1) v += __shfl_xor(v, o);
    return v;
}

__device__ __forceinline__ void transpose_item(const float* W, int K, int N, bf16_t* WT, const float* gain, LAS float* scr, int item, int lane) {
    const int nblk = N / 32, kb = item / nblk, nb = item % nblk, k0 = 64 * kb, n0 = 32 * nb;
    { const int ksub = lane >> 3, n4 = (lane & 7) * 4; f32x4 v[8];
#pragma unroll
      for (int j = 0; j < 8; ++j) v[j] = *(const f32x4*)(W + (size_t)(k0 + 8 * j + ksub) * N + n0 + n4);
#pragma unroll
      for (int j = 0; j < 8; ++j) { const int kk = 8 * j + ksub; const float gsc = gain ? gain[k0 + kk] : 1.f;
          scr[kk * 33 + n4] = v[j].x * gsc; scr[kk * 33 + n4 + 1] = v[j].y * gsc; scr[kk * 33 + n4 + 2] = v[j].z * gsc; scr[kk * 33 + n4 + 3] = v[j].w * gsc; } }
    asm volatile("s_waitcnt lgkmcnt(0)" ::: "memory");
    const int c = lane & 7;
#pragma unroll
    for (int j = 0; j < 4; ++j) { const int n = (lane >> 3) + 8 * j; const LAS float* s = scr + (8 * c) * 33 + n;
        u32x4 o; o.x = pk2(s[0 * 33], s[1 * 33]); o.y = pk2(s[2 * 33], s[3 * 33]); o.z = pk2(s[4 * 33], s[5 * 33]); o.w = pk2(s[6 * 33], s[7 * 33]);
        *(u32x4*)(WT + (size_t)(n0 + n) * K + k0 + 8 * c) = o; }
    asm volatile("s_waitcnt lgkmcnt(0)" ::: "memory");
}
__device__ __forceinline__ void transpose_all(const float* W, int K, int N, bf16_t* WT, const float* gain, LAS float* scr, int gw, int NGW, int lane) {
    const int items = (K / 64) * (N / 32);
    for (int it = gw; it < items; it += NGW) transpose_item(W, K, N, WT, gain, scr, it, lane);
}

__device__ __forceinline__ int t5_bucket(int rel) {
    const int n = rel < 0 ? -rel : rel; int bk;
    if (n < 8) bk = n; else { int j = (31 - __clz(n * n)) - 6; bk = 8 + j; if (bk > 15) bk = 15; }
    return bk + (rel > 0 ? 16 : 0);
}

constexpr int KP = 272;
__device__ __forceinline__ void attn_phase(LAS unsigned char* lds, bf16_t* Q, const bf16_t* KV, const float* biasT, const float* sink, unsigned* queue) {
    int tid = threadIdx.x; asm volatile("" : "+v"(tid));
    const int wave = __builtin_amdgcn_readfirstlane(tid >> 6), lane = tid & 63, r = lane & 31, h = lane >> 5;
    LAS unsigned char* Kb = lds; LAS unsigned char* Vb = lds + 128 * KP; LAS float* bt = (LAS float*)(lds + 2 * 128 * KP);
    const int qt = wave & 3, hl = wave >> 2;
    LAS int* qslot = (LAS int*)(lds + 2 * 128 * KP + 16384);
    LAS unsigned char* ostage = lds + 90112 + wave * (32 * KP);
    __syncthreads();
    for (int e = tid; e < 4096; e += 512) bt[e] = biasT[e];
    if (tid == 0) qslot[0] = (int)__hip_atomic_fetch_add(queue, 1u, __ATOMIC_RELAXED, __HIP_MEMORY_SCOPE_AGENT);
    __syncthreads();
    int item = qslot[0];
    while (item < BATCH * 64 * 4) {
        int nxt = 0;
        if (tid == 0) nxt = (int)__hip_atomic_fetch_add(queue, 1u, __ATOMIC_RELAXED, __HIP_MEMORY_SCOPE_AGENT);
        const int hp = item & 1, kvh = (item >> 1) & 1, qi = (item >> 2) & 63, b = item >> 8;
        const int head = kvh * 4 + hp * 2 + hl;
        const size_t qrow = (size_t)b * SEQ + qi * 128 + qt * 32 + r;
        bf16x8 qf[8];
#pragma unroll
        for (int ks = 0; ks < 8; ++ks) qf[ks] = *(const bf16x8*)(Q + qrow * 1024 + head * 128 + 16 * ks + 8 * h);
        const float sink2 = sink[head] * LOG2E;
        float mrun = sink2, lrun = 0.f;
        f32x16 O[4];
#pragma unroll
        for (int dt = 0; dt < 4; ++dt)
#pragma unroll
            for (int i = 0; i < 16; ++i) O[dt][i] = 0.f;
        u32x4 kreg[4], vreg[4];
        const int kb_lo = qi > 0 ? -1 : 0, kb_hi = qi < 63 ? 1 : 0;
#define ATT_LOAD(kbv) do { const bf16_t* kbase = KV + ((size_t)b * SEQ + (qi + (kbv)) * 128) * 512 + kvh * 128; \
            _Pragma("unroll") for (int c = 0; c < 4; ++c) { const int ch = tid + 512 * c, row = ch >> 4, c16 = ch & 15; \
                kreg[c] = *(const u32x4*)(kbase + (size_t)row * 512 + c16 * 8); vreg[c] = *(const u32x4*)(kbase + (size_t)row * 512 + 256 + c16 * 8); } } while (0)
        ATT_LOAD(kb_lo);
#pragma unroll 1
        for (int kb = kb_lo; kb <= kb_hi; ++kb) {
            __syncthreads();
#pragma unroll
            for (int c = 0; c < 4; ++c) { const int ch = tid + 512 * c, row = ch >> 4, c16 = ch & 15;
                *(LAS u32x4*)(Kb + row * KP + c16 * 16) = kreg[c]; *(LAS u32x4*)(Vb + row * KP + c16 * 16) = vreg[c]; }
            __syncthreads();
            if (kb < kb_hi) ATT_LOAD(kb + 1);
#pragma unroll 1
            for (int sub = 0; sub < 2; ++sub) {
                if (kb == -1 && sub == 0 && qt >= 2) continue;
                if (kb == 1 && sub == 1 && qt <= 1) continue;
                f32x16 sa[2];
#pragma unroll
                for (int i = 0; i < 16; ++i) { sa[0][i] = 0.f; sa[1][i] = 0.f; }
#pragma unroll
                for (int kt = 0; kt < 2; ++kt) {
                    bf16x8 kf[8];
#pragma unroll
                    for (int ks = 0; ks < 8; ++ks) kf[ks] = *(const LAS bf16x8*)(Kb + (64 * sub + 32 * kt + r) * KP + (16 * ks + 8 * h) * 2);
                    __builtin_amdgcn_sched_barrier(0);
#pragma unroll
                    for (int ks = 0; ks < 8; ++ks) sa[kt] = __builtin_amdgcn_mfma_f32_32x32x16_bf16(kf[ks], qf[ks], sa[kt], 0, 0, 0);
                    __builtin_amdgcn_sched_barrier(0);
                }
                const LAS float* btl = bt + head * 512 + (kb * 128 + 64 * sub + 4 * h - 32 * qt - r + 256);
                float mx = -3.0e38f;
#pragma unroll
                for (int kt = 0; kt < 2; ++kt) { float bv[16];
#pragma unroll
                    for (int i = 0; i < 16; ++i) bv[i] = btl[32 * kt + (i & 3) + 8 * (i >> 2)];
#pragma unroll
                    for (int i = 0; i < 16; ++i) { const float sv = sa[kt][i] + bv[i]; sa[kt][i] = sv; mx = fmaxf(mx, sv); } }
                mx = fmaxf(mx, __shfl_xor(mx, 32));
                const float mnew = fmaxf(mrun, mx), alpha = __builtin_amdgcn_exp2f(mrun - mnew);
                const bool grew = mnew > mrun;
                mrun = mnew; lrun *= alpha;
                if (__builtin_amdgcn_ballot_w64(grew) != 0ull) {
#pragma unroll
                    for (int dt = 0; dt < 4; ++dt)
#pragma unroll
                        for (int i = 0; i < 16; ++i) O[dt][i] *= alpha; }
                float ls = 0.f;
#pragma unroll
                for (int kt = 0; kt < 2; ++kt)
#pragma unroll
                    for (int i = 0; i < 16; ++i) { const float p = __builtin_amdgcn_exp2f(sa[kt][i] - mnew); sa[kt][i] = p; ls += p; }
                lrun += ls;
#pragma unroll
                for (int kt = 0; kt < 2; ++kt)
#pragma unroll
                    for (int s2 = 0; s2 < 2; ++s2) {
                        u32x4 pw; pw.x = pk2(sa[kt][8 * s2 + 0], sa[kt][8 * s2 + 1]); pw.y = pk2(sa[kt][8 * s2 + 2], sa[kt][8 * s2 + 3]); pw.z = pk2(sa[kt][8 * s2 + 4], sa[kt][8 * s2 + 5]); pw.w = pk2(sa[kt][8 * s2 + 6], sa[kt][8 * s2 + 7]);
                        const bf16x8 pf = __builtin_bit_cast(bf16x8, pw);
                        const int key0 = 64 * sub + 32 * kt + 16 * s2 + 4 * h + ((lane & 15) >> 2);
                        const LAS unsigned char* vp = Vb + key0 * KP + ((lane >> 4) & 1) * 32 + (lane & 3) * 8;
                        s16x4 lo[4], hi[4];
#pragma unroll
                        for (int dt = 0; dt < 4; ++dt) { lo[dt] = __builtin_amdgcn_ds_read_tr16_b64_v4i16((LAS s16x4*)(vp + dt * 64)); hi[dt] = __builtin_amdgcn_ds_read_tr16_b64_v4i16((LAS s16x4*)(vp + 8 * KP + dt * 64)); }
#pragma unroll
                        for (int dt = 0; dt < 4; ++dt) {
                            const bf16x8 va = __builtin_shufflevector(lo[dt], hi[dt], 0, 1, 2, 3, 4, 5, 6, 7);
                            O[dt] = __builtin_amdgcn_mfma_f32_32x32x16_bf16(va, pf, O[dt], 0, 0, 0); } }
            }
        }
#undef ATT_LOAD
        const float ltot = lrun + __shfl_xor(lrun, 32) + __builtin_amdgcn_exp2f(sink2 - mrun);
        const float inv = 1.f / ltot;
#pragma unroll
        for (int dt = 0; dt < 4; ++dt)
#pragma unroll
            for (int g4 = 0; g4 < 4; ++g4) { u32x2 w; w.x = pk2(O[dt][4 * g4] * inv, O[dt][4 * g4 + 1] * inv); w.y = pk2(O[dt][4 * g4 + 2] * inv, O[dt][4 * g4 + 3] * inv);
                *(LAS u32x2*)(ostage + r * KP + (32 * dt + 8 * g4 + 4 * h) * 2) = w; }
        bf16_t* obase = Q + ((size_t)b * SEQ + qi * 128 + qt * 32) * 1024 + head * 128;
#pragma unroll
        for (int i = 0; i < 8; ++i) { const int c = lane + 64 * i, row = c >> 4, c16 = c & 15;
            const u32x4 w = *(const LAS u32x4*)(ostage + row * KP + c16 * 16);
            *(u32x4*)(obase + (size_t)row * 1024 + c16 * 8) = w; }
        if (tid == 0) qslot[0] = nxt;
        __syncthreads();
        item = qslot[0];
    }
    __syncthreads();
}

constexpr int LRU_T = 128, LRU_NCH = SEQ / LRU_T, LRU_TASKS = BATCH * 8 * 2;
constexpr int XCF_P = 68, RAW_P = 256;
constexpr int LRU_RAW0 = 0, LRU_RAW1 = LRU_T * RAW_P, LRU_XCF = 2 * LRU_T * RAW_P, LRU_GATE = LRU_XCF + LRU_T * XCF_P * 4, LRU_PF = LRU_GATE + LRU_T * 128, LRU_EX = LRU_PF + LRU_T * 128;
static_assert(LRU_EX + 2 * 64 * 2 * 4 <= LDS_BYTES, "lru lds");
__device__ __forceinline__ float neg_expm1(float x, float a) {
    float p = 1.f + x * 0.2f; p = 1.f + x * 0.25f * p; p = 1.f + x * (1.f / 3.f) * p; p = 1.f + x * 0.5f * p;
    const float small = -x * p, big = __builtin_fmaf(-a, a, 1.f);
    return x < -0.25f ? big : small;
}
constexpr int XC_T = 128;
__device__ __forceinline__ void xc_produce(const bf16_t* XR, bf16_t* XC, const float* conv_w, const float* conv_b, unsigned* flags, unsigned ready, int pw, int NP) {
    int tid = threadIdx.x; asm volatile("" : "+v"(tid));
    const int c8t = tid & 15, trow = tid >> 4;
    const __amdgpu_buffer_rsrc_t xrs = __builtin_amdgcn_make_buffer_rsrc(XC, 0, (int)((size_t)M * 1024 * 2), 0x00020000);
    constexpr int NJ = 64 * (SEQ / XC_T);
    u32x4 xv[2][4][4];
#define XC_LOAD(u, jj) do { const int c_ = (jj) >> 6, p_ = (jj) & 63; const size_t base_ = ((size_t)(p_ >> 3) * SEQ) * 1024 + (size_t)(p_ & 7) * 128 + c8t * 8; \
        _Pragma("unroll") for (int i = 0; i < 4; ++i) _Pragma("unroll") for (int q = 0; q < 4; ++q) { int sq = c_ * XC_T + trow + 32 * i + q - 2; sq = sq < 0 ? 0 : (sq >= SEQ ? SEQ - 1 : sq); \
            xv[u][i][q] = *(const u32x4*)(XR + base_ + (size_t)sq * 1024); } } while (0)
    int pprev = -1; float cwr[5][8];
#pragma unroll
    for (int q = 0; q < 5; ++q)
#pragma unroll
        for (int k = 0; k < 8; ++k) cwr[q][k] = 0.f;
    if (pw < NJ) { XC_LOAD(0, pw); XC_LOAD(1, (pw + NP < NJ ? pw + NP : pw)); }
    for (int j = pw; j < NJ; j += 2 * NP) {
        const bool two = (j + NP < NJ);
#pragma unroll
        for (int u = 0; u < 2; ++u) {
            const int jj = (u && two) ? j + NP : j;
            const int c = jj >> 6, pair = jj & 63, b = pair >> 3, n = pair & 7;
            const size_t col = (size_t)n * 128 + c8t * 8;
            if (pair != pprev) {
#pragma unroll
                for (int q = 0; q < 5; ++q) { const float* src = (q < 4 ? conv_w + q * 1024 : conv_b) + col; const f32x4 w0 = *(const f32x4*)src, w1 = *(const f32x4*)(src + 4);
                    cwr[q][0] = w0.x; cwr[q][1] = w0.y; cwr[q][2] = w0.z; cwr[q][3] = w0.w; cwr[q][4] = w1.x; cwr[q][5] = w1.y; cwr[q][6] = w1.z; cwr[q][7] = w1.w; }
                pprev = pair; }
            if (u == 0 || two) {
#pragma unroll
                for (int i = 0; i < 4; ++i) { const int t = trow + 32 * i;
                    float xc[8];
#pragma unroll
                    for (int k = 0; k < 8; ++k) xc[k] = cwr[4][k];
#pragma unroll
                    for (int q = 0; q < 4; ++q) { const int sq = c * XC_T + t + q - 2; u32x4 v = xv[u][i][q]; if (sq < 0 || sq >= SEQ) v = (u32x4){0u, 0u, 0u, 0u};
                        xc[0] += bflo(v.x) * cwr[q][0]; xc[1] += bfhi(v.x) * cwr[q][1]; xc[2] += bflo(v.y) * cwr[q][2]; xc[3] += bfhi(v.y) * cwr[q][3];
                        xc[4] += bflo(v.z) * cwr[q][4]; xc[5] += bfhi(v.z) * cwr[q][5]; xc[6] += bflo(v.w) * cwr[q][6]; xc[7] += bfhi(v.w) * cwr[q][7]; }
                    u32x4 w; w.x = pk2(xc[0], xc[1]); w.y = pk2(xc[2], xc[3]); w.z = pk2(xc[4], xc[5]); w.w = pk2(xc[6], xc[7]);
                    __builtin_amdgcn_raw_buffer_store_b128(w, xrs, (unsigned)((((size_t)b * SEQ + c * XC_T + t) * 1024 + col) * 2), 0,   16); } }
        }
        if (j + 2 * NP < NJ) { XC_LOAD(0, j + 2 * NP); XC_LOAD(1, (j + 3 * NP < NJ ? j + 3 * NP : j + 2 * NP)); asm volatile("s_waitcnt vmcnt(40)" ::: "memory"); }
        else asm volatile("s_waitcnt vmcnt(8)" ::: "memory");
        __syncthreads();
        if (tid == 0 && j >= pw + 2 * NP) { const int jp = j - 2 * NP;
            __hip_atomic_store(flags + 64 * (jp & 63) + (jp >> 6), ready, __ATOMIC_RELAXED, __HIP_MEMORY_SCOPE_AGENT);
            __hip_atomic_store(flags + 64 * ((jp + NP) & 63) + ((jp + NP) >> 6), ready, __ATOMIC_RELAXED, __HIP_MEMORY_SCOPE_AGENT); }
    }
    asm volatile("s_waitcnt vmcnt(0)" ::: "memory");
    __syncthreads();
    if (tid == 0 && pw < NJ) { int jl = pw; while (jl + 2 * NP < NJ) jl += 2 * NP;
        __hip_atomic_store(flags + 64 * (jl & 63) + (jl >> 6), ready, __ATOMIC_RELAXED, __HIP_MEMORY_SCOPE_AGENT);
        if (jl + NP < NJ) __hip_atomic_store(flags + 64 * ((jl + NP) & 63) + ((jl + NP) >> 6), ready, __ATOMIC_RELAXED, __HIP_MEMORY_SCOPE_AGENT); }
#undef XC_LOAD
}
__device__ __forceinline__ void lru_stream(LAS unsigned char* lds, const bf16_t* XR, bf16_t* GR, bf16_t* T1, bf16_t* XC, const float* conv_w, const float* conv_b, const bf16_t* WG, const float* b_r, const float* b_i,
                                           const float* lam, int task, unsigned* flags, unsigned ready) {
    int tid = threadIdx.x; asm volatile("" : "+v"(tid));
    const int wave = __builtin_amdgcn_readfirstlane(tid >> 6), lane = tid & 63, chl = lane & 15, qd = lane >> 4, cg = wave & 3, th = wave >> 2;
    LAS float* xcf = (LAS float*)(lds + LRU_XCF); LAS unsigned char* gtl = lds + LRU_GATE; LAS unsigned char* pfl = lds + LRU_PF; LAS float* ex = (LAS float*)(lds + LRU_EX);
    const int b = task >> 4, n = (task >> 1) & 7, h2 = task & 1;
    const int chh = cg * 16 + chl, chb = h2 * 64 + chh, ch = n * 128 + chb;
    const int c8t = tid & 15; const bool own = (c8t >> 3) == h2;
    const size_t colg = (size_t)n * 128 + h2 * 64;
    __syncthreads();
#define LRU_LOAD_XC(cc) do { _Pragma("unroll") for (int i = 0; i < 4; ++i) { const int e = tid + 512 * i, rr = e >> 4, key = ((rr >> 4) & 3) * 4 + (rr & 3); \
            __builtin_amdgcn_global_load_lds((const unsigned*)(XC + ((size_t)b * SEQ + (cc) * LRU_T + rr) * 1024 + n * 128 + ((e & 15) ^ key) * 8), (LAS unsigned*)(lds + ((cc) & 1) * (LRU_T * RAW_P) + wave * 1024 + i * 8192), 16, 0, 0); } } while (0)
#define LRU_LOAD_TILE(src, dstl, cc) do { _Pragma("unroll") for (int i = 0; i < 2; ++i) { const int e = tid + 512 * i; \
            __builtin_amdgcn_global_load_lds((const unsigned*)((src) + ((size_t)b * SEQ + (cc) * LRU_T + (e >> 3)) * 1024 + colg + (e & 7) * 8), (LAS unsigned*)((dstl) + wave * 1024 + i * 8192), 16, 0, 0); } } while (0)
#pragma unroll
    for (int dir = 0; dir < 2; ++dir) {
        bf16x8 bw[2][4];
#pragma unroll
        for (int gi = 0; gi < 2; ++gi)
#pragma unroll
            for (int ks = 0; ks < 4; ++ks) bw[gi][ks] = *(const bf16x8*)(WG + ((size_t)((dir * 2 + gi) * 8 + n) * 128 + chb) * 128 + 32 * ks + 8 * qd);
        const float nbr = -LOG2E * b_r[dir * 1024 + ch], nbi = -LOG2E * b_i[dir * 1024 + ch], cl2 = -8.f * LOG2E * log1pf(expf(-lam[dir * 1024 + ch]));
        float hcar = 0.f;
        unsigned* fl = flags + 64 * (task >> 1);
        if (!dir && tid == 0) {
            for (int k = 0; k < 8; ++k) while (__hip_atomic_load(fl + k, __ATOMIC_RELAXED, __HIP_MEMORY_SCOPE_AGENT) < ready) __builtin_amdgcn_s_sleep(2);
            __builtin_amdgcn_fence(__ATOMIC_ACQUIRE, "agent"); asm volatile("s_waitcnt vmcnt(0)" ::: "memory"); }
        __syncthreads();
        LRU_LOAD_XC(dir ? LRU_NCH - 1 : 0);
        u32x4 gcur[2], pcur[2], gnxt[2], pnxt[2];
#pragma unroll
        for (int i = 0; i < 2; ++i) { gcur[i] = (u32x4){0u, 0u, 0u, 0u}; pcur[i] = gcur[i]; gnxt[i] = gcur[i]; pnxt[i] = gcur[i]; }
#define LRU_LOAD_GP(gd, pd, cc) do { _Pragma("unroll") for (int i = 0; i < 2; ++i) { const int e = tid + 512 * i; const size_t o_ = ((size_t)b * SEQ + (cc) * LRU_T + (e >> 3)) * 1024 + colg + (e & 7) * 8; \
            gd[i] = *(const u32x4*)(GR + o_); pd[i] = *(const u32x4*)(T1 + o_); } } while (0)
        if (dir) LRU_LOAD_GP(gcur, pcur, LRU_NCH - 1);
#pragma unroll 1
        for (int it = 0; it < LRU_NCH; ++it) {
            const int c = dir ? LRU_NCH - 1 - it : it;
            const size_t row0 = (size_t)b * SEQ + c * LRU_T;
            if (!dir && ((c + 1) & 7) == 0 && it + 1 < LRU_NCH && tid == 0) {
                for (int k = 1; k <= 8; ++k) while (__hip_atomic_load(fl + c + k, __ATOMIC_RELAXED, __HIP_MEMORY_SCOPE_AGENT) < ready) __builtin_amdgcn_s_sleep(2);
                __builtin_amdgcn_fence(__ATOMIC_ACQUIRE, "agent"); asm volatile("s_waitcnt vmcnt(0)" ::: "memory"); }
            if (it == 0) asm volatile("s_waitcnt vmcnt(0)" ::: "memory"); else if (dir) asm volatile("s_waitcnt vmcnt(6)" ::: "memory"); else asm volatile("s_waitcnt vmcnt(2)" ::: "memory");
            __syncthreads();
            if (it + 1 < LRU_NCH) LRU_LOAD_XC(dir ? c - 1 : c + 1);
            if (dir && it + 1 < LRU_NCH) LRU_LOAD_GP(gnxt, pnxt, c - 1);
            const LAS unsigned char* img = lds + (c & 1) * (LRU_T * RAW_P);
            f32x4 acc[2][4];
#pragma unroll
            for (int gi = 0; gi < 2; ++gi)
#pragma unroll
                for (int mt = 0; mt < 4; ++mt) acc[gi][mt] = (f32x4){0.f, 0.f, 0.f, 0.f};
#pragma unroll
            for (int ks = 0; ks < 4; ++ks) {
                bf16x8 af[4];
#pragma unroll
                for (int mt = 0; mt < 4; ++mt) { const int tok = th * 64 + (chl >> 2) * 16 + 4 * mt + (chl & 3); af[mt] = *(const LAS bf16x8*)(img + tok * RAW_P + (((4 * ks + qd) ^ chl) << 4)); }
#pragma unroll
                for (int gi = 0; gi < 2; ++gi)
#pragma unroll
                    for (int mt = 0; mt < 4; ++mt) acc[gi][mt] = __builtin_amdgcn_mfma_f32_16x16x32_bf16(af[mt], bw[gi][ks], acc[gi][mt], 0, 0, 0);
            }
#pragma unroll
            for (int mt = 0; mt < 4; ++mt)
#pragma unroll
                for (int j = 0; j < 4; ++j) { const float x = __builtin_bit_cast(float, (unsigned)*(const LAS unsigned short*)(img + (th * 64 + qd * 16 + 4 * mt + j) * RAW_P + ((((chb >> 3) ^ (4 * qd)) ^ j) << 4) + (chb & 7) * 2) << 16);
                    const float e1 = __builtin_amdgcn_exp2f(__builtin_fmaf(acc[0][mt][j], -LOG2E, nbr)), e2 = __builtin_amdgcn_exp2f(__builtin_fmaf(acc[1][mt][j], -LOG2E, nbi));
                    const float rg = __builtin_amdgcn_rcpf(1.f + e1), ig = __builtin_amdgcn_rcpf(1.f + e2);
                    const float a = __builtin_amdgcn_exp2f(rg * cl2), mult = __builtin_amdgcn_sqrtf(__builtin_fmaf(-a, a, 1.f));
                    acc[0][mt][j] = a; acc[1][mt][j] = mult * ig * x; }
            float As = 1.f, Hs = 0.f;
#pragma unroll
            for (int kk = 0; kk < 16; ++kk) { const int k = dir ? 15 - kk : kk; const float a = acc[0][k >> 2][k & 3], u = acc[1][k >> 2][k & 3]; As *= a; Hs = a * Hs + u; }
            float Aq[4], Hq[4];
#pragma unroll
            for (int q = 0; q < 4; ++q) { Aq[q] = __shfl(As, chl + 16 * q); Hq[q] = __shfl(Hs, chl + 16 * q); }
            float Aw = 1.f, Hw = 0.f;
#pragma unroll
            for (int qq = 0; qq < 4; ++qq) { const int q = dir ? 3 - qq : qq; Aw *= Aq[q]; Hw = Aq[q] * Hw + Hq[q]; }
            if (qd == 0) { ex[(th * 64 + chh) * 2] = Aw; ex[(th * 64 + chh) * 2 + 1] = Hw; }
            __syncthreads();
            const float Ao = ex[((1 - th) * 64 + chh) * 2], Ho = ex[((1 - th) * 64 + chh) * 2 + 1];
            const bool first = (th == dir);
            const float A1 = first ? Aw : Ao, H1 = first ? Hw : Ho, A2 = first ? Ao : Aw, H2 = first ? Ho : Hw;
            const float hmid = A1 * hcar + H1;
            float h = first ? hcar : hmid;
            hcar = A2 * hmid + H2;
#pragma unroll
            for (int qq = 0; qq < 3; ++qq) { const int q = dir ? 3 - qq : qq; if (dir ? (q > qd) : (q < qd)) h = Aq[q] * h + Hq[q]; }
#pragma unroll
            for (int kk = 0; kk < 16; ++kk) { const int k = dir ? 15 - kk : kk; h = acc[0][k >> 2][k & 3] * h + acc[1][k >> 2][k & 3]; xcf[(th * 64 + qd * 16 + k) * XCF_P + chh] = h; }
            __syncthreads();
#pragma unroll
            for (int i = 0; i < 2; ++i) { const int e = tid + 512 * i, t = e >> 3, c8 = e & 7;
                const u32x4 gv = gcur[i]; const f32x4 y0 = *(const LAS f32x4*)(xcf + t * XCF_P + c8 * 8), y1 = *(const LAS f32x4*)(xcf + t * XCF_P + c8 * 8 + 4);
                float o[8] = {y0.x, y0.y, y0.z, y0.w, y1.x, y1.y, y1.z, y1.w};
                if (dir) { const u32x4 pv = pcur[i];
                    o[0] += bflo(pv.x); o[1] += bfhi(pv.x); o[2] += bflo(pv.y); o[3] += bfhi(pv.y); o[4] += bflo(pv.z); o[5] += bfhi(pv.z); o[6] += bflo(pv.w); o[7] += bfhi(pv.w);
                    const float gg[8] = {bflo(gv.x), bfhi(gv.x), bflo(gv.y), bfhi(gv.y), bflo(gv.z), bfhi(gv.z), bflo(gv.w), bfhi(gv.w)};
#pragma unroll
                    for (int j = 0; j < 8; ++j) o[j] *= gg[j]; }
                u32x4 w; w.x = pk2(o[0], o[1]); w.y = pk2(o[2], o[3]); w.z = pk2(o[4], o[5]); w.w = pk2(o[6], o[7]);
                *(u32x4*)((dir ? GR : T1) + (row0 + t) * 1024 + colg + c8 * 8) = w; }
            if (dir) {
#pragma unroll
                for (int i = 0; i < 2; ++i) { gcur[i] = gnxt[i]; pcur[i] = pnxt[i]; } }
        }
    }
#undef LRU_LOAD_XC
#undef LRU_LOAD_TILE
#undef LRU_LOAD_GP
    asm volatile("s_waitcnt vmcnt(0)" ::: "memory");
    __syncthreads();
}
#define XB_TMO      128
#define XB_XCNT(j)  (256  + 64 * (j))
#define XB_XSUB(j)  (1280 + 64 * (j))
#define XB_XGEN(j)  (2304 + 64 * (j))
#define XB_TOP      3328
#define XB_TOPGEN   3392
#define XCD_BAR_WORDS 3456
#define XB_SPIN_CAP (1u << 22)
__device__ __forceinline__ unsigned xb_ld(unsigned* p)              { return __hip_atomic_load(p, __ATOMIC_RELAXED, __HIP_MEMORY_SCOPE_AGENT); }
__device__ __forceinline__ unsigned xb_add(unsigned* p, unsigned v) { return __hip_atomic_fetch_add(p, v, __ATOMIC_RELAXED, __HIP_MEMORY_SCOPE_AGENT); }
__device__ __forceinline__ unsigned xb_xcc_id() { return (unsigned)__builtin_amdgcn_s_getreg((3 << 11) | 20) & 0xFu; }
#define XB_SPIN(cond, bar) do { unsigned _sp = 0; while (cond) { __builtin_amdgcn_s_sleep(1); \
    if ((++_sp & 255u) == 0u) { if (xb_ld(&(bar)[XB_TMO])) break; if (_sp > XB_SPIN_CAP) { atomicAdd(&(bar)[XB_TMO], 1u); break; } } } } while (0)
struct XcdBarrier { unsigned* bar; unsigned x; };
__device__ __forceinline__ XcdBarrier xcd_barrier_post(unsigned* bar) {
    XcdBarrier b; b.bar = bar; b.x = xb_xcc_id();
    if (threadIdx.x == 0) (void)xb_add(&bar[XB_XCNT(b.x)], 1u);
    return b;
}
__device__ __forceinline__ void xcd_barrier_complete(unsigned* bar, unsigned x, unsigned& nloc, unsigned& nx) {
    const unsigned G = gridDim.x * gridDim.y * gridDim.z;
    unsigned sum, cnt, mine, sp = 0u;
    for (;;) {
        sum = 0u; cnt = 0u; mine = 0u;
#pragma unroll
        for (unsigned j = 0; j < 16; ++j) { const unsigned c = xb_ld(&bar[XB_XCNT(j)]); sum += c; cnt += (c > 0u) ? 1u : 0u; mine = (j == x) ? c : mine; }
        if (sum == G) break;
        __builtin_amdgcn_s_sleep(1);
        if ((++sp & 255u) == 0u) { if (xb_ld(&bar[XB_TMO])) break; if (sp > XB_SPIN_CAP) { atomicAdd(&bar[XB_TMO], 1u); break; } }
    }
    nloc = mine > 0u ? mine : 1u; nx = cnt > 0u ? cnt : 1u;
}
__device__ __forceinline__ void xcd_barrier(const XcdBarrier& b, unsigned& nloc_s, unsigned& nx_s) {
    asm volatile("s_waitcnt vmcnt(0)" ::: "memory");
    __syncthreads();
    if (threadIdx.x == 0) {
        unsigned* bar = b.bar;
        __builtin_amdgcn_s_waitcnt(0);
        unsigned nloc = nloc_s, nx = nx_s;
        if (nloc == 0u) { xcd_barrier_complete(bar, b.x, nloc, nx); nloc_s = nloc; nx_s = nx; }
        const unsigned old = xb_add(&bar[XB_XSUB(b.x)], 1u);
        const unsigned gen = old / nloc;
        if (old + 1u == (gen + 1u) * nloc) {
            __builtin_amdgcn_fence(__ATOMIC_RELEASE, "agent");
            asm volatile("s_waitcnt vmcnt(0)" ::: "memory");
            const unsigned og = xb_add(&bar[XB_TOP], 1u);
            const unsigned tg = og / nx;
            if (og + 1u == (tg + 1u) * nx) xb_add(&bar[XB_TOPGEN], 1u);
            else XB_SPIN(xb_ld(&bar[XB_TOPGEN]) == tg, bar);
            __builtin_amdgcn_fence(__ATOMIC_ACQUIRE, "agent");
            xb_add(&bar[XB_XGEN(b.x)], 1u);
            asm volatile("s_waitcnt vmcnt(0)" ::: "memory");
        } else {
            XB_SPIN(xb_ld(&bar[XB_XGEN(b.x)]) == gen, bar);
            __builtin_amdgcn_fence(__ATOMIC_ACQUIRE, "agent");
            asm volatile("s_waitcnt vmcnt(0)" ::: "memory");
        }
    }
    __syncthreads();
}

__device__ __forceinline__ void sub_barrier(unsigned* ctr, unsigned target) {
    asm volatile("s_waitcnt vmcnt(0)" ::: "memory");
    __syncthreads();
    if (threadIdx.x == 0) {
        __builtin_amdgcn_s_waitcnt(0);
        __builtin_amdgcn_fence(__ATOMIC_RELEASE, "agent");
        asm volatile("s_waitcnt vmcnt(0)" ::: "memory");
        (void)xb_add(ctr, 1u);
        unsigned sp = 0;
        while (xb_ld(ctr) < target) { __builtin_amdgcn_s_sleep(2); if (++sp > (1u << 24)) break; }
        __builtin_amdgcn_fence(__ATOMIC_ACQUIRE, "agent");
        asm volatile("s_waitcnt vmcnt(0)" ::: "memory");
    }
    __syncthreads();
}

#ifndef PHASE_MASK
#define PHASE_MASK 0xFFFF
#endif
#define PH(k) if ((PHASE_MASK >> (k)) & 1)
__global__ void __launch_bounds__(512, 2) fwd_megakernel(Args args) {
    extern __shared__ __attribute__((aligned(16))) unsigned char lds_raw[];
    LAS unsigned char* lds = (LAS unsigned char*)lds_raw;
    cg::grid_group grid = cg::this_grid();
    const int tid = threadIdx.x, lane = tid & 63, wave = __builtin_amdgcn_readfirstlane(tid >> 6);
    const int G = gridDim.x, wg = blockIdx.x, gw = wg * 8 + wave, NGW = G * 8;
    unsigned char* ws = args.ws;
    const XcdBarrier xbar = xcd_barrier_post((unsigned*)(ws + WS_CTL)); unsigned xb_nloc = 0u, xb_nx = 0u;
    const float* x_in = args.in[0]; float* out = args.out;
    bf16_t* WinT = (bf16_t*)(ws + WS_WIN); bf16_t* WoaT = (bf16_t*)(ws + WS_WOA); bf16_t* WolT = (bf16_t*)(ws + WS_WOL); bf16_t* WoutT = (bf16_t*)(ws + WS_WOUT);
    bf16_t* WupT = (bf16_t*)(ws + WS_WUP); bf16_t* WdnT = (bf16_t*)(ws + WS_WDN); bf16_t* WGT = (bf16_t*)(ws + WS_WG);
    float* biasT = (float*)(ws + WS_MISC); float* ss = (float*)(ws + WS_SS); unsigned* queue = (unsigned*)(ws + WS_CTL + 32768); unsigned* xcflags = (unsigned*)(ws + WS_CTL + 40960);
    bf16_t* xb = (bf16_t*)(ws + WS_XB); bf16_t* P = (bf16_t*)(ws + WS_P);

#ifdef PROBE_A
    unsigned long long tprev = __builtin_amdgcn_s_memrealtime(); float pa = 0.f, pb = 0.f;
#define STAMP(k) do { const unsigned long long tn = __builtin_amdgcn_s_memrealtime(); const float dt = (float)(tn - tprev) * 0.01f; tprev = tn; if ((PROBE_A >> (k)) & 1) pa += dt; if ((PROBE_B >> (k)) & 1) pb += dt; } while (0)
#else
#define STAMP(k) do {} while (0)
#endif
    PH(0) {
        LAS float* scr = (LAS float*)(lds + wave * 16384);
#define CONVERT_LAYER(lw, gwv, ngwv) do { const int l_ = (lw); \
            constexpr int I_IN = (D / 64) * (NIN / 32), I_DD = (D / 64) * (D / 32), I_UP = (D / 64) * (FF / 32), I_DN = (FF / 64) * (D / 32), I_G = 2 * 16 * 8; \
            _Pragma("unroll 1") for (int it = (gwv); it < I_IN + 3 * I_DD + I_UP + I_DN + I_G; it += (ngwv)) { \
                int r_ = it; const float* W_; bf16_t* WT_; const float* gn_ = nullptr; int K_ = D, N_ = D; \
                if (r_ < I_IN) { W_ = args.in[1] + (size_t)l_ * D * NIN; WT_ = WinT + (size_t)l_ * NIN * D; gn_ = args.in[14] + l_ * D; N_ = NIN; } \
                else if ((r_ -= I_IN) < 3 * I_DD) { const int m_ = r_ / I_DD; r_ -= m_ * I_DD; W_ = args.in[2 + m_] + (size_t)l_ * D * D; WT_ = (m_ == 0 ? WoaT : (m_ == 1 ? WolT : WoutT)) + (size_t)l_ * D * D; } \
                else if ((r_ -= 3 * I_DD) < I_UP) { W_ = args.in[16] + (size_t)l_ * D * FF; WT_ = WupT + (size_t)l_ * FF * D; gn_ = args.in[15] + l_ * D; N_ = FF; } \
                else if ((r_ -= I_UP) < I_DN) { W_ = args.in[17] + (size_t)l_ * FF * D; WT_ = WdnT + (size_t)l_ * D * FF; K_ = FF; } \
                else { r_ -= I_DN; const int g_ = r_ >> 7, mat_ = l_ * 16 + ((r_ >> 3) & 15); r_ &= 7; K_ = 128; N_ = 128; \
                    W_ = args.in[g_ ? 11 : 9] + (size_t)mat_ * 16384; WT_ = WGT + (size_t)((mat_ >> 3) * 16 + g_ * 8 + (mat_ & 7)) * 16384; } \
                transpose_item(W_, K_, N_, WT_, gn_, scr, r_, lane); } } while (0)
        CONVERT_LAYER(0, gw, NGW);
        for (int m0 = 2 * gw; m0 < M; m0 += 2 * NGW) {
            f32x4 v[2][4]; float sq[2];
#pragma unroll
            for (int r2 = 0; r2 < 2; ++r2) { const f32x4* xr = (const f32x4*)(x_in + (size_t)(m0 + r2) * D) + lane;
#pragma unroll
                for (int j = 0; j < 4; ++j) v[r2][j] = xr[64 * j]; }
#pragma unroll
            for (int r2 = 0; r2 < 2; ++r2) { float s = 0.f;
#pragma unroll
                for (int j = 0; j < 4; ++j) s += (v[r2][j].x * v[r2][j].x + v[r2][j].y * v[r2][j].y) + (v[r2][j].z * v[r2][j].z + v[r2][j].w * v[r2][j].w);
                sq[r2] = wave_sum(s);
                u32x2* o8 = (u32x2*)(xb + (size_t)(m0 + r2) * D) + lane;
#pragma unroll
                for (int j = 0; j < 4; ++j) { u32x2 w; w.x = pk2(v[r2][j].x, v[r2][j].y); w.y = pk2(v[r2][j].z, v[r2][j].w); o8[64 * j] = w; }
                if (lane < 16) ss[(size_t)(m0 + r2) * 16 + lane] = lane == 0 ? sq[r2] : 0.f; }
        }
        if (wg == 0 && tid < DEPTH) queue[tid * 64] = 0u;
        for (int idx = wg * 512 + tid; idx < 8 * 512; idx += G * 512) { const int hh = idx >> 9, rel = (idx & 511) - 256;
            biasT[idx] = (rel < -128 || rel > 128) ? -1.0e30f : args.in[6][t5_bucket(rel) * 8 + hh] * LOG2E; }
    }
    __syncthreads();
    grid.sync(); STAMP(0);

#pragma unroll 1
    for (int l = 0; l < DEPTH; ++l) {
        PH(1) { pg8::Gemm g{xb, WinT + (size_t)l * NIN * D, M, NIN, D}; pg8::StaticOrder S; S.init(M, NIN, G, wg); pg8::EpiIn E{P, ss, 0}; pg8::gemm_phase(lds, g, S, E); }
        xcd_barrier(xbar, xb_nloc, xb_nx); STAMP(1);
        const bf16_t* WGl = WGT + (size_t)l * 32 * 16384;
        const int GH = G >> 1;
        if (wg < GH) {
            PH(2) { for (int tk = wg; tk < LRU_TASKS; tk += GH) { const int task = (GH == 128) ? (((tk >> 4) << 4) | ((tk & 7) << 1) | ((tk >> 3) & 1)) : tk;     lru_stream(lds, P + P_XR, P + P_GR, (bf16_t*)out, (bf16_t*)out + (size_t)M * 1024, args.in[7] + l * 4096, args.in[8] + l * 1024, WGl, args.in[10] + l * 2048, args.in[12] + l * 2048, args.in[13] + l * 2048, task, xcflags, (unsigned)(l + 1)); } }
        } else {
            PH(2) xc_produce(P + P_XR, (bf16_t*)out + (size_t)M * 1024, args.in[7] + l * 4096, args.in[8] + l * 1024, xcflags, (unsigned)(l + 1), wg - GH, G - GH);
            PH(3) attn_phase(lds, P + P_Q, P + P_KV, biasT, args.in[5] + l * 8, queue + l * 64);
            PH(0) if (l + 1 < DEPTH) { int tidc = threadIdx.x; asm volatile("" : "+v"(tidc)); const int lane = tidc & 63, wv = __builtin_amdgcn_readfirstlane(tidc >> 6); LAS float* scr = (LAS float*)(lds + wv * 16384);
                CONVERT_LAYER(l + 1, (wg - GH) * 8 + wv, (G - GH) * 8); }
        }
        STAMP(2);
        xcd_barrier(xbar, xb_nloc, xb_nx); STAMP(3);
        PH(6) { pg8::Gemm g{P + P_Q, WoaT + (size_t)l * D * D, M, D, D}; pg8::StaticOrder S; S.init(M, D, G, wg); pg8::EpiGate<0> E{P + P_GA, P + P_GB, nullptr}; pg8::gemm_phase(lds, g, S, E); }
        STAMP(6);
        PH(7) { pg8::Gemm g{P + P_GR, WolT + (size_t)l * D * D, M, D, D}; pg8::StaticOrder S; S.init(M, D, G, wg); pg8::EpiGate<1> E{P + P_GA, P + P_GB, nullptr}; pg8::gemm_phase(lds, g, S, E); }
        xcd_barrier(xbar, xb_nloc, xb_nx); STAMP(7);
        PH(8) { pg8::Gemm g{P + P_GA, WoutT + (size_t)l * D * D, M, D, D}; pg8::StaticOrder S; S.init(M, D, G, wg); pg8::EpiRes E{xb, ss}; pg8::gemm_phase(lds, g, S, E); }
        xcd_barrier(xbar, xb_nloc, xb_nx); STAMP(8);
        PH(9) { pg8::Gemm g{xb, WupT + (size_t)l * FF * D, M, FF, D}; pg8::StaticOrder S; S.init(M, FF, G, wg); pg8::EpiUp E{P, ss}; pg8::gemm_phase(lds, g, S, E); }
        xcd_barrier(xbar, xb_nloc, xb_nx); STAMP(9);
        PH(10) { pg8::Gemm g{P, WdnT + (size_t)l * D * FF, M, D, FF}; pg8::StaticOrder S; S.init(M, D, G, wg); pg8::EpiRes E{xb, ss}; pg8::gemm_phase(lds, g, S, E); }
        xcd_barrier(xbar, xb_nloc, xb_nx); STAMP(10);
    }
#ifdef PROBE_A
    if (wg == 0 && tid == 0) { biasT[8192] = exp2f(rintf(log2f(pa) * 3.f) * (1.f / 3.f)); biasT[8193] = exp2f(rintf(log2f(pb) * 3.f) * (1.f / 3.f)) * 0.001f; }
    __threadfence(); xcd_barrier(xbar, xb_nloc, xb_nx);
    const float probeA = biasT[8192], probeB = biasT[8193];
#endif
    PH(11) {
        int tidf = threadIdx.x; asm volatile("" : "+v"(tidf));
        const int lane = tidf & 63, gw = wg * 8 + __builtin_amdgcn_readfirstlane(tidf >> 6);
        const float* gfin = args.in[18];
        f32x4 gv[4];
#pragma unroll
        for (int j = 0; j < 4; ++j) gv[j] = ((const f32x4*)gfin)[lane + 64 * j];
        for (int m0 = 2 * gw; m0 < M; m0 += 2 * NGW) {
            u32x2 t[2][4];
#pragma unroll
            for (int r2 = 0; r2 < 2; ++r2) { const u32x2* xi = (const u32x2*)(xb + (size_t)(m0 + r2) * D) + lane;
#pragma unroll
                for (int j = 0; j < 4; ++j) t[r2][j] = xi[64 * j]; }
#pragma unroll
            for (int r2 = 0; r2 < 2; ++r2) { f32x4 v[4]; float s = 0.f;
#pragma unroll
                for (int j = 0; j < 4; ++j) { v[j] = (f32x4){bflo(t[r2][j].x), bfhi(t[r2][j].x), bflo(t[r2][j].y), bfhi(t[r2][j].y)}; s += (v[j].x * v[j].x + v[j].y * v[j].y) + (v[j].z * v[j].z + v[j].w * v[j].w); }
                s = wave_sum(s);
                const float rs = 1.f / sqrtf(s * (1.f / 1024.f) + 1e-6f);
                f32x4* xr = (f32x4*)(out + (size_t)(m0 + r2) * D) + lane;
#pragma unroll
                for (int j = 0; j < 4; ++j) {
#ifdef PROBE_A
                    f32x4 o = v[j] * rs * gv[j] + probeB; if (m0 + r2 == 0 && lane == 0 && j == 0) o.x += probeA; xr[64 * j] = o;
#else
                    xr[64 * j] = v[j] * rs * gv[j];
#endif
                } }
        }
    }
}

extern "C" void kernel_launch(void* const* d_in, const int* in_sizes, int n_in, void* d_out, int out_size, void* d_ws, size_t ws_size, hipStream_t stream) {
    static int grid = 0;
    if (grid == 0) {
        if (n_in != 19 || out_size != M * D || ws_size < WS_END) { fprintf(stderr, "kernel_launch: unexpected problem: n_in %d out %d ws %zu (need %zu)\n", n_in, out_size, ws_size, (size_t)WS_END); grid = -1; return; }
        int dev = 0, cus = 0, per_cu = 0;
        hipGetDevice(&dev);
        hipDeviceGetAttribute(&cus, hipDeviceAttributeMultiprocessorCount, dev);
        if (hipFuncSetAttribute((const void*)fwd_megakernel, hipFuncAttributeMaxDynamicSharedMemorySize, LDS_BYTES) != hipSuccess) { fprintf(stderr, "kernel_launch: hipFuncSetAttribute failed\n"); grid = -1; return; }
        if (hipOccupancyMaxActiveBlocksPerMultiprocessor(&per_cu, (const void*)fwd_megakernel, 512, LDS_BYTES) != hipSuccess || per_cu < 1) { fprintf(stderr, "kernel_launch: occupancy query gave %d\n", per_cu); per_cu = 1; }
        (void)hipGetLastError();
        grid = cus * per_cu;
    }
    if (grid < 0) return;
    if (hipMemsetAsync((char*)d_ws + WS_CTL, 0, CTL_BYTES, stream) != hipSuccess) { fprintf(stderr, "kernel_launch: memset failed\n"); return; }
    Args a{};
    for (int i = 0; i < 19; ++i) a.in[i] = (const float*)d_in[i];
    a.out = (float*)d_out; a.ws = (unsigned char*)d_ws;
    void* kargs[] = {&a};
    hipError_t e = hipLaunchCooperativeKernel((const void*)fwd_megakernel, dim3(grid), dim3(512), kargs, LDS_BYTES, stream);
    if (e != hipSuccess) fprintf(stderr, "kernel_launch: cooperative launch failed: %s (grid %d)\n", hipGetErrorString(e), grid);
}
```

```cpp
#include <hip/hip_runtime.h>
#include <hip/hip_cooperative_groups.h>
#include <cstdio>
#include <cstdint>
namespace cg = cooperative_groups;

#define LAS __attribute__((address_space(3)))
typedef unsigned short bf16_t;
typedef short bf16x8 __attribute__((ext_vector_type(8)));
typedef short s16x4 __attribute__((ext_vector_type(4)));
typedef float f32x2 __attribute__((ext_vector_type(2)));
typedef float f32x4 __attribute__((ext_vector_type(4)));
typedef float f32x16 __attribute__((ext_vector_type(16)));
typedef unsigned u32x2 __attribute__((ext_vector_type(2)));
typedef unsigned u32x4 __attribute__((ext_vector_type(4)));
typedef __bf16 bf16x2n __attribute__((ext_vector_type(2)));

constexpr int BATCH = 8, SEQ = 8192, D = 1024, DEPTH = 4, NIN = 5632, FF = 4096;
constexpr int M = BATCH * SEQ;
constexpr float LOG2E = 1.4426950408889634f;
constexpr float QSCALE = 0.08838834764831845f * LOG2E;

constexpr size_t MiB = 1u << 20;
constexpr size_t WS_WIN = 0, WS_WOA = 44 * MiB, WS_WOL = 52 * MiB, WS_WOUT = 60 * MiB, WS_WUP = 68 * MiB, WS_WDN = 100 * MiB, WS_WG = 132 * MiB;
constexpr size_t WS_MISC = 136 * MiB, WS_SS = 137 * MiB, WS_AGG = 141 * MiB, WS_CARRY = 157 * MiB, WS_XB = 165 * MiB, WS_P = 293 * MiB;
constexpr size_t P_Q = 0, P_KV = (size_t)M * 1024, P_XR = P_KV + (size_t)M * 512, P_GR = P_XR + (size_t)M * 1024, P_GA = P_GR + (size_t)M * 1024, P_GB = P_GA + (size_t)M * 1024;
constexpr size_t WS_END = WS_P + (P_GB + (size_t)M * 1024) * 2;
static_assert(WS_END == 997 * MiB, "ws map");
constexpr int LDS_BYTES = 163840;
constexpr int LDS_SS = 131072;
constexpr size_t WS_CTL = WS_MISC + 131072, CTL_BYTES = 65536;

__device__ __forceinline__ unsigned pk2(float a, float b) { f32x2 v = {a, b}; bf16x2n r = __builtin_convertvector(v, bf16x2n); return __builtin_bit_cast(unsigned, r); }
__device__ __forceinline__ float bflo(unsigned u) { return __builtin_bit_cast(float, u << 16); }
__device__ __forceinline__ float bfhi(unsigned u) { return __builtin_bit_cast(float, u & 0xffff0000u); }
__device__ __forceinline__ float sigmoidf_(float x) { return __builtin_amdgcn_rcpf(1.f + __expf(-x)); }

namespace pg8 {
constexpr int BM = 256, BK = 64, HALF = 128, HTB = HALF * BK * 2, STAGE_BYTES = 8 * HTB, NXCD = 8, WGM = 8;
__host__ __device__ __forceinline__ int lds_byte(int r, int c) { const int st = (r >> 4) * 2 + (c >> 5), rr = r & 15, cc = c & 31, ob = rr * 64 + cc * 2; return st * 1024 + (ob ^ (((ob >> 9) & 1) << 5)); }
__host__ __device__ __forceinline__ void stage_rc(int b, int& R, int& C) { const int st = b / 1024, sb = b % 1024, swz = sb ^ (((sb >> 9) & 1) << 5); R = (st >> 1) * 16 + swz / 64; C = (st & 1) * 32 + (swz % 64) / 2; }
__host__ __device__ __forceinline__ int perm32(int rho) { const int n = rho >> 4, i = rho & 15; return 8 * (i >> 2) + 4 * n + (i & 3); }

struct Unit { int pm, pn; };
struct Gemm { const bf16_t* A; const bf16_t* Bt; int M, N, K; };

struct StaticOrder {
    int nM, nN, nwg, G, c;
    __host__ __device__ void init(int M_, int N_, int G_, int c_) { nM = M_ / BM; nN = N_ / BM; nwg = nM * nN; G = G_; c = c_; }
    __host__ __device__ bool next(int i, Unit& u) const {
        const long L = (long)i * G + c; if (L >= nwg) return false;
        int wgid = (int)L; { const int q = nwg / NXCD, r = nwg % NXCD, xcd = wgid % NXCD, off = wgid / NXCD; wgid = (xcd < r ? xcd * (q + 1) : r * (q + 1) + (xcd - r) * q) + off; }
        const int nig = WGM * nN, gid = wgid / nig, fm = gid * WGM, gsz = (nM - fm) < WGM ? (nM - fm) : WGM;
        u.pm = fm + ((wgid % nig) % gsz); u.pn = (wgid % nig) / gsz; return true;
    }
};

__device__ __forceinline__ float row_rstd(const float* ss, int row) {
    const f32x4* p = (const f32x4*)(ss + (size_t)row * 16);
    const f32x4 a = p[0], b = p[1], c = p[2], d = p[3];
    const float s = (((a.x + a.y) + (a.z + a.w)) + ((b.x + b.y) + (b.z + b.w))) + (((c.x + c.y) + (c.z + c.w)) + ((d.x + d.y) + (d.z + d.w)));
    return __builtin_amdgcn_rsqf(s * (1.f / 1024.f) + 1e-6f);
}

__device__ __forceinline__ float row_rstd_lds(const LAS unsigned char* img, int rl) {
    const LAS f32x4* p = (const LAS f32x4*)(img + rl * 64);
    const f32x4 a = p[0], b = p[1], c = p[2], d = p[3];
    const float s = (((a.x + a.y) + (a.z + a.w)) + ((b.x + b.y) + (b.z + b.w))) + (((c.x + c.y) + (c.z + c.w)) + ((d.x + d.y) + (d.z + d.w)));
    return __builtin_amdgcn_rsqf(s * (1.f / 1024.f) + 1e-6f);
}
struct EpiIn {
    static constexpr bool PERM = true, RSTD = true;
    bf16_t* P; const float* ss; int pn_off;
    __device__ __forceinline__ void operator()(const f32x4 (&acc)[2][2][4][2], const Unit& u, int wr, int wc, int fr, int fq, const LAS unsigned char* img) const {
        const int pn = u.pn + pn_off; bf16_t* base; int ld; float sc = 1.f;
        if (pn < 4) { base = P + P_Q + pn * 256; ld = 1024; sc = QSCALE; }
        else if (pn < 6) { base = P + P_KV + (pn - 4) * 256; ld = 512; }
        else { const int t = (pn - 6) >> 2, c = (pn - 6) & 3; base = P + P_XR + (size_t)t * ((size_t)M * 1024) + c * 256; ld = 1024; }
        const bool isgate = (pn >= 10 && pn < 14);
        const int row0 = u.pm * BM + wr * 64 + fr, col0 = wc * 32 + 8 * fq;
#pragma unroll
        for (int ai = 0; ai < 2; ++ai)
#pragma unroll
            for (int m = 0; m < 4; ++m) { const int row = row0 + ai * HALF + m * 16; const float rs = row_rstd_lds(img, wr * 64 + fr + ai * HALF + m * 16) * sc; bf16_t* rowp = base + (size_t)row * ld + col0;
#pragma unroll
                for (int bj = 0; bj < 2; ++bj) { f32x4 v0 = acc[ai][bj][m][0] * rs, v1 = acc[ai][bj][m][1] * rs;
                    if (isgate) {
#pragma unroll
                        for (int j = 0; j < 4; ++j) { const float a = v0[j], b = v1[j];
                            v0[j] = a * __builtin_amdgcn_rcpf(1.f + __builtin_amdgcn_exp2f(-1.5957691216057308f * LOG2E * (a + 0.044715f * a * a * a)));
                            v1[j] = b * __builtin_amdgcn_rcpf(1.f + __builtin_amdgcn_exp2f(-1.5957691216057308f * LOG2E * (b + 0.044715f * b * b * b))); } }
                    u32x4 w; w.x = pk2(v0[0], v0[1]); w.y = pk2(v0[2], v0[3]); w.z = pk2(v1[0], v1[1]); w.w = pk2(v1[2], v1[3]);
                    *(u32x4*)(rowp + bj * HALF) = w; } }
    }
};
struct EpiUp {
    static constexpr bool PERM = true, RSTD = true;
    bf16_t* U; const float* ss;
    __device__ __forceinline__ void operator()(const f32x4 (&acc)[2][2][4][2], const Unit& u, int wr, int wc, int fr, int fq, const LAS unsigned char* img) const {
        const int row0 = u.pm * BM + wr * 64 + fr, col0 = u.pn * BM + wc * 32 + 8 * fq;
#pragma unroll
        for (int ai = 0; ai < 2; ++ai)
#pragma unroll
            for (int m = 0; m < 4; ++m) { const int row = row0 + ai * HALF + m * 16; const float rs = row_rstd_lds(img, wr * 64 + fr + ai * HALF + m * 16); bf16_t* rowp = U + (size_t)row * FF + col0;
#pragma unroll
                for (int bj = 0; bj < 2; ++bj) { f32x4 v0 = acc[ai][bj][m][0] * rs, v1 = acc[ai][bj][m][1] * rs;
#pragma unroll
                    for (int j = 0; j < 4; ++j) { const float a = fmaxf(v0[j], 0.f), b = fmaxf(v1[j], 0.f); v0[j] = a * a; v1[j] = b * b; }
                    u32x4 w; w.x = pk2(v0[0], v0[1]); w.y = pk2(v0[2], v0[3]); w.z = pk2(v1[0], v1[1]); w.w = pk2(v1[2], v1[3]);
                    *(u32x4*)(rowp + bj * HALF) = w; } }
    }
};
template <int STAGE> struct EpiGate {
    static constexpr bool PERM = true, RSTD = false;
    bf16_t* GA; const bf16_t* GB; const float* ss;
    __device__ __forceinline__ void operator()(const f32x4 (&acc)[2][2][4][2], const Unit& u, int wr, int wc, int fr, int fq, const LAS unsigned char* img) const {
        const int row0 = u.pm * BM + wr * 64 + fr, col0 = u.pn * BM + wc * 32 + 8 * fq;
#pragma unroll
        for (int ai = 0; ai < 2; ++ai)
#pragma unroll
            for (int m = 0; m < 4; ++m) { const size_t off = (size_t)(row0 + ai * HALF + m * 16) * 1024 + col0;
#pragma unroll
                for (int bj = 0; bj < 2; ++bj) {
                    const u32x4 g = *(const u32x4*)((STAGE == 0 ? (const bf16_t*)GA : GB) + off + bj * HALF);
                    float s[8] = {bflo(g.x), bfhi(g.x), bflo(g.y), bfhi(g.y), bflo(g.z), bfhi(g.z), bflo(g.w), bfhi(g.w)};
                    float o[8];
#pragma unroll
                    for (int j = 0; j < 8; ++j) o[j] = sigmoidf_(s[j]) * acc[ai][bj][m][j >> 2][j & 3];
                    if (STAGE == 1) { const u32x4 t = *(const u32x4*)(GA + off + bj * HALF);
                        o[0] += bflo(t.x); o[1] += bfhi(t.x); o[2] += bflo(t.y); o[3] += bfhi(t.y); o[4] += bflo(t.z); o[5] += bfhi(t.z); o[6] += bflo(t.w); o[7] += bfhi(t.w); }
                    u32x4 w; w.x = pk2(o[0], o[1]); w.y = pk2(o[2], o[3]); w.z = pk2(o[4], o[5]); w.w = pk2(o[6], o[7]);
                    *(u32x4*)(GA + off + bj * HALF) = w; } }
    }
};
struct EpiRes {
    static constexpr bool PERM = true, RSTD = false;
    bf16_t* xb; float* ss;
    __device__ __forceinline__ void operator()(const f32x4 (&acc)[2][2][4][2], const Unit& u, int wr, int wc, int fr, int fq, const LAS unsigned char* img) const {
        const int row0 = u.pm * BM + wr * 64 + fr, col0 = u.pn * BM + wc * 32 + 8 * fq;
#pragma unroll
        for (int ai = 0; ai < 2; ++ai)
#pragma unroll
            for (int m = 0; m < 4; ++m) { const int row = row0 + ai * HALF + m * 16; const size_t off = (size_t)row * 1024 + col0; float sq = 0.f;
#pragma unroll
                for (int bj = 0; bj < 2; ++bj) { const u32x4 t = *(const u32x4*)(xb + off + bj * HALF);
                    float o[8] = {bflo(t.x), bfhi(t.x), bflo(t.y), bfhi(t.y), bflo(t.z), bfhi(t.z), bflo(t.w), bfhi(t.w)};
#pragma unroll
                    for (int j = 0; j < 8; ++j) { o[j] += acc[ai][bj][m][j >> 2][j & 3]; sq += o[j] * o[j]; }
                    u32x4 w; w.x = pk2(o[0], o[1]); w.y = pk2(o[2], o[3]); w.z = pk2(o[4], o[5]); w.w = pk2(o[6], o[7]);
                    *(u32x4*)(xb + off + bj * HALF) = w; }
                sq += __shfl_xor(sq, 16); sq += __shfl_xor(sq, 32);
                if (fq == 0) ss[(size_t)row * 16 + u.pn * 4 + wc] = sq; }
    }
};

template <class Epi>
__device__ __forceinline__ void gemm_phase(LAS unsigned char* lds, const Gemm g, const StaticOrder& S, const Epi& E) {
    int tid = threadIdx.x; asm volatile("" : "+v"(tid));
    const int wid = __builtin_amdgcn_readfirstlane(tid >> 6), lane = tid & 63, wr = wid >> 2, wc = wid & 3, fr = lane & 15, fq = lane >> 4;
    const int K = g.K, nt = K / BK;
    unsigned voffA[2], voffB[2];
#pragma unroll
    for (int i = 0; i < 2; ++i) { int R, C; stage_rc(tid * 16 + i * 8192, R, C); const int Rb = Epi::PERM ? ((R & ~31) + perm32(R & 31)) : R;
        voffA[i] = (unsigned)(R * K + C) * 2u; voffB[i] = (unsigned)(Rb * K + C) * 2u; }
    const size_t kstep = (size_t)(BK * 2);
    const size_t hstep = (size_t)HALF * K * 2;
    const size_t tstep = 2 * hstep;
    const unsigned ldsw = (unsigned)wid * 1024u;
    const int aoff = lds_byte(wr * 64 + fr, fq * 8), boff = lds_byte(wc * 32 + fr, fq * 8);
#define PG8_SA(b, h) (((b) * 2 + (h)) * HTB)
#define PG8_SB(b, h) ((4 + (b) * 2 + (h)) * HTB)
#define PG8_STAGE(bufoff, gbase, voff) do { _Pragma("unroll") for (int _i = 0; _i < 2; ++_i) \
        __builtin_amdgcn_global_load_lds((const unsigned*)((const char*)(gbase) + (voff)[_i]), (LAS unsigned*)(lds + (bufoff) + ldsw + _i * 8192), 16, 0, 0); } while (0)
#define PG8_LDA(dst, b, h) do { _Pragma("unroll") for (int m = 0; m < 4; ++m) _Pragma("unroll") for (int k = 0; k < 2; ++k) dst[m][k] = *(const LAS bf16x8*)(lds + PG8_SA(b, h) + aoff + m * 2048 + k * 1024); } while (0)
#define PG8_LDB(dst, b, h) do { _Pragma("unroll") for (int n = 0; n < 2; ++n) _Pragma("unroll") for (int k = 0; k < 2; ++k) dst[n][k] = *(const LAS bf16x8*)(lds + PG8_SB(b, h) + boff + n * 2048 + k * 1024); } while (0)
#define PG8_MMA(ai, bj, At, Bt) do { __builtin_amdgcn_s_setprio(1); _Pragma("unroll") for (int m = 0; m < 4; ++m) _Pragma("unroll") for (int n = 0; n < 2; ++n) _Pragma("unroll") for (int k = 0; k < 2; ++k) \
        acc[ai][bj][m][n] = __builtin_amdgcn_mfma_f32_16x16x32_bf16(Bt[n][k], At[m][k], acc[ai][bj][m][n], 0, 0, 0); __builtin_amdgcn_s_setprio(0); } while (0)
#define PG8_WAIT_V(n) asm volatile("s_waitcnt vmcnt(" #n ")" ::: "memory")
#define PG8_WAIT_L(n) asm volatile("s_waitcnt lgkmcnt(" #n ")" ::: "memory")
#define PG8_BAR __builtin_amdgcn_s_barrier()
#define PG8_SCHED __builtin_amdgcn_sched_barrier(0)
    Unit cur, nxt; int ui = 0;
    if (!S.next(0, cur)) return;
    f32x4 acc[2][2][4][2];
#pragma unroll
    for (int a = 0; a < 2; ++a)
#pragma unroll
        for (int b = 0; b < 2; ++b)
#pragma unroll
            for (int m = 0; m < 4; ++m)
#pragma unroll
                for (int n = 0; n < 2; ++n) acc[a][b][m][n] = (f32x4){0.f, 0.f, 0.f, 0.f};
    bf16x8 At[4][2], B0[2][2], B1[2][2];
    const char* cA = (const char*)g.A + (size_t)cur.pm * tstep; const char* cB = (const char*)g.Bt + (size_t)cur.pn * tstep;
    PG8_STAGE(PG8_SB(0, 0), cB, voffB); PG8_STAGE(PG8_SB(0, 1), cB + hstep, voffB); PG8_STAGE(PG8_SA(0, 0), cA, voffA); PG8_STAGE(PG8_SA(0, 1), cA + hstep, voffA);
    if (wr == 1) PG8_BAR;
    PG8_WAIT_V(2); PG8_BAR;
    PG8_STAGE(PG8_SB(1, 0), cB + kstep, voffB); PG8_STAGE(PG8_SA(1, 0), cA + kstep, voffA); PG8_STAGE(PG8_SB(1, 1), cB + hstep + kstep, voffB);
    PG8_WAIT_V(6); PG8_BAR;
    for (;;) {
        const bool has_next = S.next(ui + 1, nxt);
        const char* nA = has_next ? (const char*)g.A + (size_t)nxt.pm * tstep : cA; const char* nB = has_next ? (const char*)g.Bt + (size_t)nxt.pn * tstep : cB;
        LAS unsigned char* img = lds + LDS_SS + (ui & 1) * 16384;
        if constexpr (Epi::RSTD) {
#pragma unroll
            for (int i = 0; i < 2; ++i) __builtin_amdgcn_global_load_lds((const unsigned*)(E.ss + ((size_t)cur.pm * BM) * 16 + (size_t)(tid + 512 * i) * 4), (LAS unsigned*)(img + wid * 1024 + i * 8192), 16, 0, 0);
        }
        for (int t = 0; t < nt; t += 2) {
            const bool last = (t == nt - 2);
            const char* a1 = cA + (size_t)(t + 1) * kstep;
            const char* a2 = last ? nA : cA + (size_t)(t + 2) * kstep; const char* b2 = last ? nB : cB + (size_t)(t + 2) * kstep;
            const char* a3 = a2 + kstep; const char* b3 = b2 + kstep;
            PG8_LDB(B0, 0, 0); PG8_LDB(B1, 0, 1); PG8_SCHED; PG8_LDA(At, 0, 0); PG8_STAGE(PG8_SA(1, 1), a1 + hstep, voffA);
            PG8_WAIT_V(8); PG8_WAIT_L(0); PG8_BAR; PG8_MMA(0, 0, At, B0); PG8_MMA(0, 1, At, B1); PG8_BAR; PG8_SCHED;
            PG8_LDA(At, 0, 1); PG8_STAGE(PG8_SB(0, 0), b2, voffB); PG8_STAGE(PG8_SB(0, 1), b2 + hstep, voffB); PG8_STAGE(PG8_SA(0, 0), a2, voffA);
            PG8_WAIT_V(8); PG8_WAIT_L(0); PG8_BAR; PG8_MMA(1, 0, At, B0); PG8_MMA(1, 1, At, B1); PG8_BAR; PG8_SCHED;
            PG8_LDB(B0, 1, 0); PG8_LDB(B1, 1, 1); PG8_SCHED; PG8_LDA(At, 1, 0); PG8_STAGE(PG8_SA(0, 1), a2 + hstep, voffA);
            PG8_WAIT_V(8); PG8_WAIT_L(0); PG8_BAR; PG8_MMA(0, 0, At, B0); PG8_MMA(0, 1, At, B1); PG8_BAR; PG8_SCHED;
            PG8_LDA(At, 1, 1); PG8_STAGE(PG8_SB(1, 0), b3, voffB); PG8_STAGE(PG8_SB(1, 1), b3 + hstep, voffB); PG8_STAGE(PG8_SA(1, 0), a3, voffA);
            PG8_WAIT_V(8); PG8_WAIT_L(0); PG8_BAR; PG8_MMA(1, 0, At, B0); PG8_MMA(1, 1, At, B1); PG8_BAR; PG8_SCHED;
        }
        if (wr == 0) PG8_BAR;
        E(acc, cur, wr, wc, fr, fq, img);
        if (!has_next) break;
#pragma unroll
        for (int a = 0; a < 2; ++a)
#pragma unroll
            for (int b = 0; b < 2; ++b)
#pragma unroll
                for (int m = 0; m < 4; ++m)
#pragma unroll
                    for (int n = 0; n < 2; ++n) acc[a][b][m][n] = (f32x4){0.f, 0.f, 0.f, 0.f};
        cur = nxt; cA = nA; cB = nB; ++ui;
        if (wr == 1) PG8_BAR;
    }
    PG8_WAIT_V(0);
    PG8_BAR;
#undef PG8_SA
#undef PG8_SB
#undef PG8_STAGE
#undef PG8_LDA
#undef PG8_LDB
#undef PG8_MMA
#undef PG8_WAIT_V
#undef PG8_WAIT_L
#undef PG8_BAR
#undef PG8_SCHED
}
}

struct Args { const float* in[19]; float* out; unsigned char* ws; };

__device__ __forceinline__ float wave_sum(float v) {
#pragma unroll
    for (int o = 1; o < 64; o <<= 1) v += __shfl_xor(v, o);
    return v;
}

__device__ __forceinline__ void transpose_item(const float* W, int K, int N, bf16_t* WT, const float* gain, LAS float* scr, int item, int lane) {
    const int nblk = N / 32, kb = item / nblk, nb = item % nblk, k0 = 64 * kb, n0 = 32 * nb;
    { const int ksub = lane >> 3, n4 = (lane & 7) * 4; f32x4 v[8];
#pragma unroll
      for (int j = 0; j < 8; ++j) v[j] = *(const f32x4*)(W + (size_t)(k0 + 8 * j + ksub) * N + n0 + n4);
#pragma unroll
      for (int j = 0; j < 8; ++j) { const int kk = 8 * j + ksub; const float gsc = gain ? gain[k0 + kk] : 1.f;
          scr[kk * 33 + n4] = v[j].x * gsc; scr[kk * 33 + n4 + 1] = v[j].y * gsc; scr[kk * 33 + n4 + 2] = v[j].z * gsc; scr[kk * 33 + n4 + 3] = v[j].w * gsc; } }
    asm volatile("s_waitcnt lgkmcnt(0)" ::: "memory");
    const int c = lane & 7;
#pragma unroll
    for (int j = 0; j < 4; ++j) { const int n = (lane >> 3) + 8 * j; const LAS float* s = scr + (8 * c) * 33 + n;
        u32x4 o; o.x = pk2(s[0 * 33], s[1 * 33]); o.y = pk2(s[2 * 33], s[3 * 33]); o.z = pk2(s[4 * 33], s[5 * 33]); o.w = pk2(s[6 * 33], s[7 * 33]);
        *(u32x4*)(WT + (size_t)(n0 + n) * K + k0 + 8 * c) = o; }
    asm volatile("s_waitcnt lgkmcnt(0)" ::: "memory");
}
__device__ __forceinline__ void transpose_all(const float* W, int K, int N, bf16_t* WT, const float* gain, LAS float* scr, int gw, int NGW, int lane) {
    const int items = (K / 64) * (N / 32);
    for (int it = gw; it < items; it += NGW) transpose_item(W, K, N, WT, gain, scr, it, lane);
}

__device__ __forceinline__ int t5_bucket(int rel) {
    const int n = rel < 0 ? -rel : rel; int bk;
    if (n < 8) bk = n; else { int j = (31 - __clz(n * n)) - 6; bk = 8 + j; if (bk > 15) bk = 15; }
    return bk + (rel > 0 ? 16 : 0);
}

constexpr int KP = 272;
__device__ __forceinline__ void attn_phase(LAS unsigned char* lds, bf16_t* Q, const bf16_t* KV, const float* biasT, const float* sink, unsigned* queue) {
    int tid = threadIdx.x; asm volatile("" : "+v"(tid));
    const int wave = __builtin_amdgcn_readfirstlane(tid >> 6), lane = tid & 63, r = lane & 31, h = lane >> 5;
    LAS unsigned char* Kb = lds; LAS unsigned char* Vb = lds + 128 * KP; LAS float* bt = (LAS float*)(lds + 2 * 128 * KP);
    const int qt = wave & 3, hl = wave >> 2;
    LAS int* qslot = (LAS int*)(lds + 2 * 128 * KP + 16384);
    LAS unsigned char* ostage = lds + 90112 + wave * (32 * KP);
    __syncthreads();
    for (int e = tid; e < 4096; e += 512) bt[e] = biasT[e];
    const int xq = (int)(blockIdx.x & 7u);
    const bool q8 = (gridDim.x % 16u) == 0u; const int ipq = q8 ? 256 : BATCH * 64 * 4;
    const int xqq = q8 ? xq : 0; unsigned* myq = queue + xqq * 64;
#define ATT_FETCH(dst) do { const int cnt_ = (int)__hip_atomic_fetch_add(myq, 1u, __ATOMIC_RELAXED, __HIP_MEMORY_SCOPE_AGENT); dst = cnt_ < ipq ? xqq * ipq + cnt_ : BATCH * 64 * 4; } while (0)
    if (tid == 0) { int it0; ATT_FETCH(it0); qslot[0] = it0; }
    __syncthreads();
    int item = qslot[0];
    while (item < BATCH * 64 * 4) {
        int nxt = 0;
        if (tid == 0) ATT_FETCH(nxt);
        const int hp = item & 1, kvh = (item >> 1) & 1, qi = (item >> 2) & 63, b = item >> 8;
        const int head = kvh * 4 + hp * 2 + hl;
        const size_t qrow = (size_t)b * SEQ + qi * 128 + qt * 32 + r;
        bf16x8 qf[8];
#pragma unroll
        for (int ks = 0; ks < 8; ++ks) qf[ks] = *(const bf16x8*)(Q + qrow * 1024 + head * 128 + 16 * ks + 8 * h);
        const float sink2 = sink[head] * LOG2E;
        float mrun = sink2, lrun = 0.f;
        f32x16 O[4];
#pragma unroll
        for (int dt = 0; dt < 4; ++dt)
#pragma unroll
            for (int i = 0; i < 16; ++i) O[dt][i] = 0.f;
        u32x4 kreg[4], vreg[4];
        const int kb_lo = qi > 0 ? -1 : 0, kb_hi = qi < 63 ? 1 : 0;
#define ATT_LOAD(kbv) do { const bf16_t* kbase = KV + ((size_t)b * SEQ + (qi + (kbv)) * 128) * 512 + kvh * 128; \
            _Pragma("unroll") for (int c = 0; c < 4; ++c) { const int ch = tid + 512 * c, row = ch >> 4, c16 = ch & 15; \
                kreg[c] = *(const u32x4*)(kbase + (size_t)row * 512 + c16 * 8); vreg[c] = *(const u32x4*)(kbase + (size_t)row * 512 + 256 + c16 * 8); } } while (0)
        ATT_LOAD(kb_lo);
#pragma unroll 1
        for (int kb = kb_lo; kb <= kb_hi; ++kb) {
            __syncthreads();
#pragma unroll
            for (int c = 0; c < 4; ++c) { const int ch = tid + 512 * c, row = ch >> 4, c16 = ch & 15;
                *(LAS u32x4*)(Kb + row * KP + c16 * 16) = kreg[c]; *(LAS u32x4*)(Vb + row * KP + c16 * 16) = vreg[c]; }
            __syncthreads();
            if (kb < kb_hi) ATT_LOAD(kb + 1);
#pragma unroll 1
            for (int sub = 0; sub < 2; ++sub) {
                if (kb == -1 && sub == 0 && qt >= 2) continue;
                if (kb == 1 && sub == 1 && qt <= 1) continue;
                f32x16 sa[2];
#pragma unroll
                for (int i = 0; i < 16; ++i) { sa[0][i] = 0.f; sa[1][i] = 0.f; }
#pragma unroll
                for (int kt = 0; kt < 2; ++kt) {
                    bf16x8 kf[8];
#pragma unroll
                    for (int ks = 0; ks < 8; ++ks) kf[ks] = *(const LAS bf16x8*)(Kb + (64 * sub + 32 * kt + r) * KP + (16 * ks + 8 * h) * 2);
                    __builtin_amdgcn_sched_barrier(0);
#pragma unroll
                    for (int ks = 0; ks < 8; ++ks) sa[kt] = __builtin_amdgcn_mfma_f32_32x32x16_bf16(kf[ks], qf[ks], sa[kt], 0, 0, 0);
                    __builtin_amdgcn_sched_barrier(0);
                }
                const LAS float* btl = bt + head * 512 + (kb * 128 + 64 * sub + 4 * h - 32 * qt - r + 256);
                float mx = -3.0e38f;
#pragma unroll
                for (int kt = 0; kt < 2; ++kt) { float bv[16];
#pragma unroll
                    for (int i = 0; i < 16; ++i) bv[i] = btl[32 * kt + (i & 3) + 8 * (i >> 2)];
#pragma unroll
                    for (int i = 0; i < 16; ++i) { const float sv = sa[kt][i] + bv[i]; sa[kt][i] = sv; mx = fmaxf(mx, sv); } }
                mx = fmaxf(mx, __shfl_xor(mx, 32));
                const float mnew = fmaxf(mrun, mx), alpha = __builtin_amdgcn_exp2f(mrun - mnew);
                const bool grew = mnew > mrun;
                mrun = mnew; lrun *= alpha;
                if (__builtin_amdgcn_ballot_w64(grew) != 0ull) {
#pragma unroll
                    for (int dt = 0; dt < 4; ++dt)
#pragma unroll
                        for (int i = 0; i < 16; ++i) O[dt][i] *= alpha; }
                float ls = 0.f;
#pragma unroll
                for (int kt = 0; kt < 2; ++kt)
#pragma unroll
                    for (int i = 0; i < 16; ++i) { const float p = __builtin_amdgcn_exp2f(sa[kt][i] - mnew); sa[kt][i] = p; ls += p; }
                lrun += ls;
#pragma unroll
                for (int kt = 0; kt < 2; ++kt)
#pragma unroll
                    for (int s2 = 0; s2 < 2; ++s2) {
                        u32x4 pw; pw.x = pk2(sa[kt][8 * s2 + 0], sa[kt][8 * s2 + 1]); pw.y = pk2(sa[kt][8 * s2 + 2], sa[kt][8 * s2 + 3]); pw.z = pk2(sa[kt][8 * s2 + 4], sa[kt][8 * s2 + 5]); pw.w = pk2(sa[kt][8 * s2 + 6], sa[kt][8 * s2 + 7]);
                        const bf16x8 pf = __builtin_bit_cast(bf16x8, pw);
                        const int key0 = 64 * sub + 32 * kt + 16 * s2 + 4 * h + ((lane & 15) >> 2);
                        const LAS unsigned char* vp = Vb + key0 * KP + ((lane >> 4) & 1) * 32 + (lane & 3) * 8;
                        s16x4 lo[4], hi[4];
#pragma unroll
                        for (int dt = 0; dt < 4; ++dt) { lo[dt] = __builtin_amdgcn_ds_read_tr16_b64_v4i16((LAS s16x4*)(vp + dt * 64)); hi[dt] = __builtin_amdgcn_ds_read_tr16_b64_v4i16((LAS s16x4*)(vp + 8 * KP + dt * 64)); }
#pragma unroll
                        for (int dt = 0; dt < 4; ++dt) {
                            const bf16x8 va = __builtin_shufflevector(lo[dt], hi[dt], 0, 1, 2, 3, 4, 5, 6, 7);
                            O[dt] = __builtin_amdgcn_mfma_f32_32x32x16_bf16(va, pf, O[dt], 0, 0, 0); } }
            }
        }
#undef ATT_LOAD
        const float ltot = lrun + __shfl_xor(lrun, 32) + __builtin_amdgcn_exp2f(sink2 - mrun);
        const float inv = 1.f / ltot;
#pragma unroll
        for (int dt = 0; dt < 4; ++dt)
#pragma unroll
            for (int g4 = 0; g4 < 4; ++g4) { u32x2 w; w.x = pk2(O[dt][4 * g4] * inv, O[dt][4 * g4 + 1] * inv); w.y = pk2(O[dt][4 * g4 + 2] * inv, O[dt][4 * g4 + 3] * inv);
                *(LAS u32x2*)(ostage + r * KP + (32 * dt + 8 * g4 + 4 * h) * 2) = w; }
        bf16_t* obase = Q + ((size_t)b * SEQ + qi * 128 + qt * 32) * 1024 + head * 128;
#pragma unroll
        for (int i = 0; i < 8; ++i) { const int c = lane + 64 * i, row = c >> 4, c16 = c & 15;
            const u32x4 w = *(const LAS u32x4*)(ostage + row * KP + c16 * 16);
            *(u32x4*)(obase + (size_t)row * 1024 + c16 * 8) = w; }
        if (tid == 0) qslot[0] = nxt;
        __syncthreads();
        item = qslot[0];
    }
    __syncthreads();
}

constexpr int LRU_T = 128, LRU_NCH = SEQ / LRU_T, LRU_TASKS = BATCH * 8 * 2;
constexpr int XCF_P = 68, RAW_P = 256;
constexpr int LRU_RAW0 = 0, LRU_RAW1 = LRU_T * RAW_P, LRU_XCF = 2 * LRU_T * RAW_P, LRU_GATE = LRU_XCF + LRU_T * XCF_P * 4, LRU_PF = LRU_GATE + LRU_T * 128, LRU_EX = LRU_PF + LRU_T * 128;
static_assert(LRU_EX + 2 * 64 * 2 * 4 <= LDS_BYTES, "lru lds");
__device__ __forceinline__ float neg_expm1(float x, float a) {
    float p = 1.f + x * 0.2f; p = 1.f + x * 0.25f * p; p = 1.f + x * (1.f / 3.f) * p; p = 1.f + x * 0.5f * p;
    const float small = -x * p, big = __builtin_fmaf(-a, a, 1.f);
    return x < -0.25f ? big : small;
}
constexpr int XC_T = 128;
__device__ __forceinline__ void xc_produce(const bf16_t* XR, bf16_t* XC, const float* conv_w, const float* conv_b, unsigned* flags, unsigned ready, int pw, int NP) {
    int tid = threadIdx.x; asm volatile("" : "+v"(tid));
    const int c8t = tid & 15, trow = tid >> 4;
    const __amdgpu_buffer_rsrc_t xrs = __builtin_amdgcn_make_buffer_rsrc(XC, 0, (int)((size_t)M * 1024 * 2), 0x00020000);
    constexpr int NJ = 64 * (SEQ / XC_T);
    u32x4 xv[2][4][4];
#define XC_LOAD(u, jj) do { const int c_ = (jj) >> 6, p_ = (jj) & 63; const size_t base_ = ((size_t)(p_ >> 3) * SEQ) * 1024 + (size_t)(p_ & 7) * 128 + c8t * 8; \
        _Pragma("unroll") for (int i = 0; i < 4; ++i) _Pragma("unroll") for (int q = 0; q < 4; ++q) { int sq = c_ * XC_T + trow + 32 * i + q - 2; sq = sq < 0 ? 0 : (sq >= SEQ ? SEQ - 1 : sq); \
            xv[u][i][q] = *(const u32x4*)(XR + base_ + (size_t)sq * 1024); } } while (0)
    int pprev = -1; float cwr[5][8];
#pragma unroll
    for (int q = 0; q < 5; ++q)
#pragma unroll
        for (int k = 0; k < 8; ++k) cwr[q][k] = 0.f;
    if (pw < NJ) { XC_LOAD(0, pw); XC_LOAD(1, (pw + NP < NJ ? pw + NP : pw)); }
    for (int j = pw; j < NJ; j += 2 * NP) {
        const bool two = (j + NP < NJ);
#pragma unroll
        for (int u = 0; u < 2; ++u) {
            const int jj = (u && two) ? j + NP : j;
            const int c = jj >> 6, pair = jj & 63, b = pair >> 3, n = pair & 7;
            const size_t col = (size_t)n * 128 + c8t * 8;
            if (pair != pprev) {
#pragma unroll
                for (int q = 0; q < 5; ++q) { const float* src = (q < 4 ? conv_w + q * 1024 : conv_b) + col; const f32x4 w0 = *(const f32x4*)src, w1 = *(const f32x4*)(src + 4);
                    cwr[q][0] = w0.x; cwr[q][1] = w0.y; cwr[q][2] = w0.z; cwr[q][3] = w0.w; cwr[q][4] = w1.x; cwr[q][5] = w1.y; cwr[q][6] = w1.z; cwr[q][7] = w1.w; }
                pprev = pair; }
            if (u == 0 || two) {
#pragma unroll
                for (int i = 0; i < 4; ++i) { const int t = trow + 32 * i;
                    float xc[8];
#pragma unroll
                    for (int k = 0; k < 8; ++k) xc[k] = cwr[4][k];
#pragma unroll
                    for (int q = 0; q < 4; ++q) { const int sq = c * XC_T + t + q - 2; u32x4 v = xv[u][i][q]; if (sq < 0 || sq >= SEQ) v = (u32x4){0u, 0u, 0u, 0u};
                        xc[0] += bflo(v.x) * cwr[q][0]; xc[1] += bfhi(v.x) * cwr[q][1]; xc[2] += bflo(v.y) * cwr[q][2]; xc[3] += bfhi(v.y) * cwr[q][3];
                        xc[4] += bflo(v.z) * cwr[q][4]; xc[5] += bfhi(v.z) * cwr[q][5]; xc[6] += bflo(v.w) * cwr[q][6]; xc[7] += bfhi(v.w) * cwr[q][7]; }
                    u32x4 w; w.x = pk2(xc[0], xc[1]); w.y = pk2(xc[2], xc[3]); w.z = pk2(xc[4], xc[5]); w.w = pk2(xc[6], xc[7]);
                    __builtin_amdgcn_raw_buffer_store_b128(w, xrs, (unsigned)((((size_t)b * SEQ + c * XC_T + t) * 1024 + col) * 2), 0,   16); } }
        }
        if (j + 2 * NP < NJ) { XC_LOAD(0, j + 2 * NP); XC_LOAD(1, (j + 3 * NP < NJ ? j + 3 * NP : j + 2 * NP)); asm volatile("s_waitcnt vmcnt(40)" ::: "memory"); }
        else asm volatile("s_waitcnt vmcnt(8)" ::: "memory");
        __syncthreads();
        if (tid == 0 && j >= pw + 2 * NP) { const int jp = j - 2 * NP;
            __hip_atomic_store(flags + 64 * (jp & 63) + (jp >> 6), ready, __ATOMIC_RELAXED, __HIP_MEMORY_SCOPE_AGENT);
            __hip_atomic_store(flags + 64 * ((jp + NP) & 63) + ((jp + NP) >> 6), ready, __ATOMIC_RELAXED, __HIP_MEMORY_SCOPE_AGENT); }
    }
    asm volatile("s_waitcnt vmcnt(0)" ::: "memory");
    __syncthreads();
    if (tid == 0 && pw < NJ) { int jl = pw; while (jl + 2 * NP < NJ) jl += 2 * NP;
        __hip_atomic_store(flags + 64 * (jl & 63) + (jl >> 6), ready, __ATOMIC_RELAXED, __HIP_MEMORY_SCOPE_AGENT);
        if (jl + NP < NJ) __hip_atomic_store(flags + 64 * ((jl + NP) & 63) + ((jl + NP) >> 6), ready, __ATOMIC_RELAXED, __HIP_MEMORY_SCOPE_AGENT); }
#undef XC_LOAD
}
__device__ __forceinline__ void lru_stream(LAS unsigned char* lds, const bf16_t* XR, bf16_t* GR, bf16_t* T1, bf16_t* XC, const float* conv_w, const float* conv_b, const bf16_t* WG, const float* b_r, const float* b_i,
                                           const float* lam, int task, unsigned* flags, unsigned ready) {
    int tid = threadIdx.x; asm volatile("" : "+v"(tid));
    const int wave = __builtin_amdgcn_readfirstlane(tid >> 6), lane = tid & 63, chl = lane & 15, qd = lane >> 4, cg = wave & 3, th = wave >> 2;
    LAS float* xcf = (LAS float*)(lds + LRU_XCF); LAS unsigned char* gtl = lds + LRU_GATE; LAS unsigned char* pfl = lds + LRU_PF; LAS float* ex = (LAS float*)(lds + LRU_EX);
    const int b = task >> 4, n = (task >> 1) & 7, h2 = task & 1;
    const int chh = cg * 16 + chl, chb = h2 * 64 + chh, ch = n * 128 + chb;
    const int c8t = tid & 15; const bool own = (c8t >> 3) == h2;
    const size_t colg = (size_t)n * 128 + h2 * 64;
    __syncthreads();
#define LRU_LOAD_XC(cc) do { _Pragma("unroll") for (int i = 0; i < 4; ++i) { const int e = tid + 512 * i, rr = e >> 4, key = ((rr >> 4) & 3) * 4 + (rr & 3); \
            __builtin_amdgcn_global_load_lds((const unsigned*)(XC + ((size_t)b * SEQ + (cc) * LRU_T + rr) * 1024 + n * 128 + ((e & 15) ^ key) * 8), (LAS unsigned*)(lds + ((cc) & 1) * (LRU_T * RAW_P) + wave * 1024 + i * 8192), 16, 0, 0); } } while (0)
#define LRU_LOAD_TILE(src, dstl, cc) do { _Pragma("unroll") for (int i = 0; i < 2; ++i) { const int e = tid + 512 * i; \
            __builtin_amdgcn_global_load_lds((const unsigned*)((src) + ((size_t)b * SEQ + (cc) * LRU_T + (e >> 3)) * 1024 + colg + (e & 7) * 8), (LAS unsigned*)((dstl) + wave * 1024 + i * 8192), 16, 0, 0); } } while (0)
#pragma unroll
    for (int dir = 0; dir < 2; ++dir) {
        bf16x8 bw[2][4];
#pragma unroll
        for (int gi = 0; gi < 2; ++gi)
#pragma unroll
            for (int ks = 0; ks < 4; ++ks) bw[gi][ks] = *(const bf16x8*)(WG + ((size_t)((dir * 2 + gi) * 8 + n) * 128 + chb) * 128 + 32 * ks + 8 * qd);
        const float nbr = -LOG2E * b_r[dir * 1024 + ch], nbi = -LOG2E * b_i[dir * 1024 + ch], cl2 = -8.f * LOG2E * log1pf(expf(-lam[dir * 1024 + ch]));
        float hcar = 0.f;
        unsigned* fl = flags + 64 * (task >> 1);
        if (!dir && tid == 0) {
            for (int k = 0; k < 8; ++k) while (__hip_atomic_load(fl + k, __ATOMIC_RELAXED, __HIP_MEMORY_SCOPE_AGENT) < ready) __builtin_amdgcn_s_sleep(2);
            __builtin_amdgcn_fence(__ATOMIC_ACQUIRE, "agent"); asm volatile("s_waitcnt vmcnt(0)" ::: "memory"); }
        __syncthreads();
        LRU_LOAD_XC(dir ? LRU_NCH - 1 : 0);
        u32x4 gcur[2], pcur[2], gnxt[2], pnxt[2];
#pragma unroll
        for (int i = 0; i < 2; ++i) { gcur[i] = (u32x4){0u, 0u, 0u, 0u}; pcur[i] = gcur[i]; gnxt[i] = gcur[i]; pnxt[i] = gcur[i]; }
#define LRU_LOAD_GP(gd, pd, cc) do { _Pragma("unroll") for (int i = 0; i < 2; ++i) { const int e = tid + 512 * i; const size_t o_ = ((size_t)b * SEQ + (cc) * LRU_T + (e >> 3)) * 1024 + colg + (e & 7) * 8; \
            gd[i] = *(const u32x4*)(GR + o_); pd[i] = *(const u32x4*)(T1 + o_); } } while (0)
        if (dir) LRU_LOAD_GP(gcur, pcur, LRU_NCH - 1);
#pragma unroll 1
        for (int it = 0; it < LRU_NCH; ++it) {
            const int c = dir ? LRU_NCH - 1 - it : it;
            const size_t row0 = (size_t)b * SEQ + c * LRU_T;
            if (!dir && ((c + 1) & 7) == 0 && it + 1 < LRU_NCH && tid == 0) {
                for (int k = 1; k <= 8; ++k) while (__hip_atomic_load(fl + c + k, __ATOMIC_RELAXED, __HIP_MEMORY_SCOPE_AGENT) < ready) __builtin_amdgcn_s_sleep(2);
                __builtin_amdgcn_fence(__ATOMIC_ACQUIRE, "agent"); asm volatile("s_waitcnt vmcnt(0)" ::: "memory"); }
            if (it == 0) asm volatile("s_waitcnt vmcnt(0)" ::: "memory"); else if (dir) asm volatile("s_waitcnt vmcnt(6)" ::: "memory"); else asm volatile("s_waitcnt vmcnt(2)" ::: "memory");
            __syncthreads();
            if (it + 1 < LRU_NCH) LRU_LOAD_XC(dir ? c - 1 : c + 1);
            if (dir && it + 1 < LRU_NCH) LRU_LOAD_GP(gnxt, pnxt, c - 1);
            const LAS unsigned char* img = lds + (c & 1) * (LRU_T * RAW_P);
            f32x4 acc[2][4];
#pragma unroll
            for (int gi = 0; gi < 2; ++gi)
#pragma unroll
                for (int mt = 0; mt < 4; ++mt) acc[gi][mt] = (f32x4){0.f, 0.f, 0.f, 0.f};
#pragma unroll
            for (int ks = 0; ks < 4; ++ks) {
                bf16x8 af[4];
#pragma unroll
                for (int mt = 0; mt < 4; ++mt) { const int tok = th * 64 + (chl >> 2) * 16 + 4 * mt + (chl & 3); af[mt] = *(const LAS bf16x8*)(img + tok * RAW_P + (((4 * ks + qd) ^ chl) << 4)); }
#pragma unroll
                for (int gi = 0; gi < 2; ++gi)
#pragma unroll
                    for (int mt = 0; mt < 4; ++mt) acc[gi][mt] = __builtin_amdgcn_mfma_f32_16x16x32_bf16(af[mt], bw[gi][ks], acc[gi][mt], 0, 0, 0);
            }
#pragma unroll
            for (int mt = 0; mt < 4; ++mt)
#pragma unroll
                for (int j = 0; j < 4; ++j) { const float x = __builtin_bit_cast(float, (unsigned)*(const LAS unsigned short*)(img + (th * 64 + qd * 16 + 4 * mt + j) * RAW_P + ((((chb >> 3) ^ (4 * qd)) ^ j) << 4) + (chb & 7) * 2) << 16);
                    const float e1 = __builtin_amdgcn_exp2f(__builtin_fmaf(acc[0][mt][j], -LOG2E, nbr)), e2 = __builtin_amdgcn_exp2f(__builtin_fmaf(acc[1][mt][j], -LOG2E, nbi));
                    const float rg = __builtin_amdgcn_rcpf(1.f + e1), ig = __builtin_amdgcn_rcpf(1.f + e2);
                    const float a = __builtin_amdgcn_exp2f(rg * cl2), mult = __builtin_amdgcn_sqrtf(__builtin_fmaf(-a, a, 1.f));
                    acc[0][mt][j] = a; acc[1][mt][j] = mult * ig * x; }
            float As = 1.f, Hs = 0.f;
#pragma unroll
            for (int kk = 0; kk < 16; ++kk) { const int k = dir ? 15 - kk : kk; const float a = acc[0][k >> 2][k & 3], u = acc[1][k >> 2][k & 3]; As *= a; Hs = a * Hs + u; }
            float Aq[4], Hq[4];
#pragma unroll
            for (int q = 0; q < 4; ++q) { Aq[q] = __shfl(As, chl + 16 * q); Hq[q] = __shfl(Hs, chl + 16 * q); }
            float Aw = 1.f, Hw = 0.f;
#pragma unroll
            for (int qq = 0; qq < 4; ++qq) { const int q = dir ? 3 - qq : qq; Aw *= Aq[q]; Hw = Aq[q] * Hw + Hq[q]; }
            if (qd == 0) { ex[(th * 64 + chh) * 2] = Aw; ex[(th * 64 + chh) * 2 + 1] = Hw; }
            __syncthreads();
            const float Ao = ex[((1 - th) * 64 + chh) * 2], Ho = ex[((1 - th) * 64 + chh) * 2 + 1];
            const bool first = (th == dir);
            const float A1 = first ? Aw : Ao, H1 = first ? Hw : Ho, A2 = first ? Ao : Aw, H2 = first ? Ho : Hw;
            const float hmid = A1 * hcar + H1;
            float h = first ? hcar : hmid;
            hcar = A2 * hmid + H2;
#pragma unroll
            for (int qq = 0; qq < 3; ++qq) { const int q = dir ? 3 - qq : qq; if (dir ? (q > qd) : (q < qd)) h = Aq[q] * h + Hq[q]; }
#pragma unroll
            for (int kk = 0; kk < 16; ++kk) { const int k = dir ? 15 - kk : kk; h = acc[0][k >> 2][k & 3] * h + acc[1][k >> 2][k & 3]; xcf[(th * 64 + qd * 16 + k) * XCF_P + chh] = h; }
            __syncthreads();
#pragma unroll
            for (int i = 0; i < 2; ++i) { const int e = tid + 512 * i, t = e >> 3, c8 = e & 7;
                const u32x4 gv = gcur[i]; const f32x4 y0 = *(const LAS f32x4*)(xcf + t * XCF_P + c8 * 8), y1 = *(const LAS f32x4*)(xcf + t * XCF_P + c8 * 8 + 4);
                float o[8] = {y0.x, y0.y, y0.z, y0.w, y1.x, y1.y, y1.z, y1.w};
                if (dir) { const u32x4 pv = pcur[i];
                    o[0] += bflo(pv.x); o[1] += bfhi(pv.x); o[2] += bflo(pv.y); o[3] += bfhi(pv.y); o[4] += bflo(pv.z); o[5] += bfhi(pv.z); o[6] += bflo(pv.w); o[7] += bfhi(pv.w);
                    const float gg[8] = {bflo(gv.x), bfhi(gv.x), bflo(gv.y), bfhi(gv.y), bflo(gv.z), bfhi(gv.z), bflo(gv.w), bfhi(gv.w)};
#pragma unroll
                    for (int j = 0; j < 8; ++j) o[j] *= gg[j]; }
                u32x4 w; w.x = pk2(o[0], o[1]); w.y = pk2(o[2], o[3]); w.z = pk2(o[4], o[5]); w.w = pk2(o[6], o[7]);
                *(u32x4*)((dir ? GR : T1) + (row0 + t) * 1024 + colg + c8 * 8) = w; }
            if (dir) {
#pragma unroll
                for (int i = 0; i < 2; ++i) { gcur[i] = gnxt[i]; pcur[i] = pnxt[i]; } }
        }
    }
#undef LRU_LOAD_XC
#undef LRU_LOAD_TILE
#undef LRU_LOAD_GP
    asm volatile("s_waitcnt vmcnt(0)" ::: "memory");
    __syncthreads();
}
#define XB_TMO      128
#define XB_XCNT(j)  (256  + 64 * (j))
#define XB_XSUB(j)  (1280 + 64 * (j))
#define XB_XGEN(j)  (2304 + 64 * (j))
#define XB_TOP      3328
#define XB_TOPGEN   3392
#define XCD_BAR_WORDS 3456
#define XB_SPIN_CAP (1u << 22)
__device__ __forceinline__ unsigned xb_ld(unsigned* p)              { return __hip_atomic_load(p, __ATOMIC_RELAXED, __HIP_MEMORY_SCOPE_AGENT); }
__device__ __forceinline__ unsigned xb_add(unsigned* p, unsigned v) { return __hip_atomic_fetch_add(p, v, __ATOMIC_RELAXED, __HIP_MEMORY_SCOPE_AGENT); }
__device__ __forceinline__ unsigned xb_xcc_id() { return (unsigned)__builtin_amdgcn_s_getreg((3 << 11) | 20) & 0xFu; }
#define XB_SPIN(cond, bar) do { unsigned _sp = 0; while (cond) { __builtin_amdgcn_s_sleep(1); \
    if ((++_sp & 255u) == 0u) { if (xb_ld(&(bar)[XB_TMO])) break; if (_sp > XB_SPIN_CAP) { atomicAdd(&(bar)[XB_TMO], 1u); break; } } } } while (0)
struct XcdBarrier { unsigned* bar; unsigned x; };
__device__ __forceinline__ XcdBarrier xcd_barrier_post(unsigned* bar) {
    XcdBarrier b; b.bar = bar; b.x = xb_xcc_id();
    if (threadIdx.x == 0) (void)xb_add(&bar[XB_XCNT(b.x)], 1u);
    return b;
}
__device__ __forceinline__ void xcd_barrier_complete(unsigned* bar, unsigned x, unsigned& nloc, unsigned& nx) {
    const unsigned G = gridDim.x * gridDim.y * gridDim.z;
    unsigned sum, cnt, mine, sp = 0u;
    for (;;) {
        sum = 0u; cnt = 0u; mine = 0u;
#pragma unroll
        for (unsigned j = 0; j < 16; ++j) { const unsigned c = xb_ld(&bar[XB_XCNT(j)]); sum += c; cnt += (c > 0u) ? 1u : 0u; mine = (j == x) ? c : mine; }
        if (sum == G) break;
        __builtin_amdgcn_s_sleep(1);
        if ((++sp & 255u) == 0u) { if (xb_ld(&bar[XB_TMO])) break; if (sp > XB_SPIN_CAP) { atomicAdd(&bar[XB_TMO], 1u); break; } }
    }
    nloc = mine > 0u ? mine : 1u; nx = cnt > 0u ? cnt : 1u;
}
__device__ __forceinline__ void xcd_barrier(const XcdBarrier& b, unsigned& nloc_s, unsigned& nx_s) {
    asm volatile("s_waitcnt vmcnt(0)" ::: "memory");
    __syncthreads();
    if (threadIdx.x == 0) {
        unsigned* bar = b.bar;
        __builtin_amdgcn_s_waitcnt(0);
        unsigned nloc = nloc_s, nx = nx_s;
        if (nloc == 0u) { xcd_barrier_complete(bar, b.x, nloc, nx); nloc_s = nloc; nx_s = nx; }
        const unsigned old = xb_add(&bar[XB_XSUB(b.x)], 1u);
        const unsigned gen = old / nloc;
        if (old + 1u == (gen + 1u) * nloc) {
            __builtin_amdgcn_fence(__ATOMIC_RELEASE, "agent");
            asm volatile("s_waitcnt vmcnt(0)" ::: "memory");
            const unsigned og = xb_add(&bar[XB_TOP], 1u);
            const unsigned tg = og / nx;
            if (og + 1u == (tg + 1u) * nx) xb_add(&bar[XB_TOPGEN], 1u);
            else XB_SPIN(xb_ld(&bar[XB_TOPGEN]) == tg, bar);
            __builtin_amdgcn_fence(__ATOMIC_ACQUIRE, "agent");
            xb_add(&bar[XB_XGEN(b.x)], 1u);
            asm volatile("s_waitcnt vmcnt(0)" ::: "memory");
        } else {
            XB_SPIN(xb_ld(&bar[XB_XGEN(b.x)]) == gen, bar);
            __builtin_amdgcn_fence(__ATOMIC_ACQUIRE, "agent");
            asm volatile("s_waitcnt vmcnt(0)" ::: "memory");
        }
    }
    __syncthreads();
}

__device__ __forceinline__ void sub_barrier(unsigned* ctr, unsigned target) {
    asm volatile("s_waitcnt vmcnt(0)" ::: "memory");
    __syncthreads();
    if (threadIdx.x == 0) {
        __builtin_amdgcn_s_waitcnt(0);
        __builtin_amdgcn_fence(__ATOMIC_RELEASE, "agent");
        asm volatile("s_waitcnt vmcnt(0)" ::: "memory");
        (void)xb_add(ctr, 1u);
        unsigned sp = 0;
        while (xb_ld(ctr) < target) { __builtin_amdgcn_s_sleep(2); if (++sp > (1u << 24)) break; }
        __builtin_amdgcn_fence(__ATOMIC_ACQUIRE, "agent");
        asm volatile("s_waitcnt vmcnt(0)" ::: "memory");
    }
    __syncthreads();
}

#ifndef PHASE_MASK
#define PHASE_MASK 0xFFFF
#endif
#define PH(k) if ((PHASE_MASK >> (k)) & 1)
__global__ void __launch_bounds__(512, 2) fwd_megakernel(Args args) {
    extern __shared__ __attribute__((aligned(16))) unsigned char lds_raw[];
    LAS unsigned char* lds = (LAS unsigned char*)lds_raw;
    cg::grid_group grid = cg::this_grid();
    const int tid = threadIdx.x, lane = tid & 63, wave = __builtin_amdgcn_readfirstlane(tid >> 6);
    const int G = gridDim.x, wg = blockIdx.x, gw = wg * 8 + wave, NGW = G * 8;
    unsigned char* ws = args.ws;
    const XcdBarrier xbar = xcd_barrier_post((unsigned*)(ws + WS_CTL)); unsigned xb_nloc = 0u, xb_nx = 0u;
    const float* x_in = args.in[0]; float* out = args.out;
    bf16_t* WinT = (bf16_t*)(ws + WS_WIN); bf16_t* WoaT = (bf16_t*)(ws + WS_WOA); bf16_t* WolT = (bf16_t*)(ws + WS_WOL); bf16_t* WoutT = (bf16_t*)(ws + WS_WOUT);
    bf16_t* WupT = (bf16_t*)(ws + WS_WUP); bf16_t* WdnT = (bf16_t*)(ws + WS_WDN); bf16_t* WGT = (bf16_t*)(ws + WS_WG);
    float* biasT = (float*)(ws + WS_MISC); float* ss = (float*)(ws + WS_SS); unsigned* queue = (unsigned*)(ws + WS_CTL + 32768); unsigned* xcflags = (unsigned*)(ws + WS_CTL + 40960);
    bf16_t* xb = (bf16_t*)(ws + WS_XB); bf16_t* P = (bf16_t*)(ws + WS_P);

#ifdef PROBE_A
    unsigned long long tprev = __builtin_amdgcn_s_memrealtime(); float pa = 0.f, pb = 0.f;
#define STAMP(k) do { const unsigned long long tn = __builtin_amdgcn_s_memrealtime(); const float dt = (float)(tn - tprev) * 0.01f; tprev = tn; if ((PROBE_A >> (k)) & 1) pa += dt; if ((PROBE_B >> (k)) & 1) pb += dt; } while (0)
#else
#define STAMP(k) do {} while (0)
#endif
    PH(0) {
        LAS float* scr = (LAS float*)(lds + wave * 16384);
#define CONVERT_LAYER(lw, gwv, ngwv) do { const int l_ = (lw); \
            constexpr int I_IN = (D / 64) * (NIN / 32), I_DD = (D / 64) * (D / 32), I_UP = (D / 64) * (FF / 32), I_DN = (FF / 64) * (D / 32), I_G = 2 * 16 * 8; \
            _Pragma("unroll 1") for (int it = (gwv); it < I_IN + 3 * I_DD + I_UP + I_DN + I_G; it += (ngwv)) { \
                int r_ = it; const float* W_; bf16_t* WT_; const float* gn_ = nullptr; int K_ = D, N_ = D; \
                if (r_ < I_IN) { W_ = args.in[1] + (size_t)l_ * D * NIN; WT_ = WinT + (size_t)l_ * NIN * D; gn_ = args.in[14] + l_ * D; N_ = NIN; } \
                else if ((r_ -= I_IN) < 3 * I_DD) { const int m_ = r_ / I_DD; r_ -= m_ * I_DD; W_ = args.in[2 + m_] + (size_t)l_ * D * D; WT_ = (m_ == 0 ? WoaT : (m_ == 1 ? WolT : WoutT)) + (size_t)l_ * D * D; } \
                else if ((r_ -= 3 * I_DD) < I_UP) { W_ = args.in[16] + (size_t)l_ * D * FF; WT_ = WupT + (size_t)l_ * FF * D; gn_ = args.in[15] + l_ * D; N_ = FF; } \
                else if ((r_ -= I_UP) < I_DN) { W_ = args.in[17] + (size_t)l_ * FF * D; WT_ = WdnT + (size_t)l_ * D * FF; K_ = FF; } \
                else { r_ -= I_DN; const int g_ = r_ >> 7, mat_ = l_ * 16 + ((r_ >> 3) & 15); r_ &= 7; K_ = 128; N_ = 128; \
                    W_ = args.in[g_ ? 11 : 9] + (size_t)mat_ * 16384; WT_ = WGT + (size_t)((mat_ >> 3) * 16 + g_ * 8 + (mat_ & 7)) * 16384; } \
                transpose_item(W_, K_, N_, WT_, gn_, scr, r_, lane); } } while (0)
        CONVERT_LAYER(0, gw, NGW);
        for (int m0 = 2 * gw; m0 < M; m0 += 2 * NGW) {
            f32x4 v[2][4]; float sq[2];
#pragma unroll
            for (int r2 = 0; r2 < 2; ++r2) { const f32x4* xr = (const f32x4*)(x_in + (size_t)(m0 + r2) * D) + lane;
#pragma unroll
                for (int j = 0; j < 4; ++j) v[r2][j] = xr[64 * j]; }
#pragma unroll
            for (int r2 = 0; r2 < 2; ++r2) { float s = 0.f;
#pragma unroll
                for (int j = 0; j < 4; ++j) s += (v[r2][j].x * v[r2][j].x + v[r2][j].y * v[r2][j].y) + (v[r2][j].z * v[r2][j].z + v[r2][j].w * v[r2][j].w);
                sq[r2] = wave_sum(s);
                u32x2* o8 = (u32x2*)(xb + (size_t)(m0 + r2) * D) + lane;
#pragma unroll
                for (int j = 0; j < 4; ++j) { u32x2 w; w.x = pk2(v[r2][j].x, v[r2][j].y); w.y = pk2(v[r2][j].z, v[r2][j].w); o8[64 * j] = w; }
                if (lane < 16) ss[(size_t)(m0 + r2) * 16 + lane] = lane == 0 ? sq[r2] : 0.f; }
        }
        if (wg == 0 && tid < DEPTH) queue[tid * 64] = 0u;
        for (int idx = wg * 512 + tid; idx < 8 * 512; idx += G * 512) { const int hh = idx >> 9, rel = (idx & 511) - 256;
            biasT[idx] = (rel < -128 || rel > 128) ? -1.0e30f : args.in[6][t5_bucket(rel) * 8 + hh] * LOG2E; }
    }
    __syncthreads();
    grid.sync(); STAMP(0);

#pragma unroll 1
    for (int l = 0; l < DEPTH; ++l) {
        PH(1) { pg8::Gemm g{xb, WinT + (size_t)l * NIN * D, M, NIN, D}; pg8::StaticOrder S; S.init(M, NIN, G, wg); pg8::EpiIn E{P, ss, 0}; pg8::gemm_phase(lds, g, S, E); }
        xcd_barrier(xbar, xb_nloc, xb_nx); STAMP(1);
        const bf16_t* WGl = WGT + (size_t)l * 32 * 16384;
        const int GH = G >> 1;
        if (wg < GH) {
            PH(2) { for (int tk = wg; tk < LRU_TASKS; tk += GH) { const int task = (GH == 128) ? (((tk >> 4) << 4) | ((tk & 7) << 1) | ((tk >> 3) & 1)) : tk;     lru_stream(lds, P + P_XR, P + P_GR, (bf16_t*)out, (bf16_t*)out + (size_t)M * 1024, args.in[7] + l * 4096, args.in[8] + l * 1024, WGl, args.in[10] + l * 2048, args.in[12] + l * 2048, args.in[13] + l * 2048, task, xcflags, (unsigned)(l + 1)); } }
        } else {
            PH(2) xc_produce(P + P_XR, (bf16_t*)out + (size_t)M * 1024, args.in[7] + l * 4096, args.in[8] + l * 1024, xcflags, (unsigned)(l + 1), wg - GH, G - GH);
            PH(3) attn_phase(lds, P + P_Q, P + P_KV, biasT, args.in[5] + l * 8, queue + l * 512);
            PH(0) if (l + 1 < DEPTH) { int tidc = threadIdx.x; asm volatile("" : "+v"(tidc)); const int lane = tidc & 63, wv = __builtin_amdgcn_readfirstlane(tidc >> 6); LAS float* scr = (LAS float*)(lds + wv * 16384);
                CONVERT_LAYER(l + 1, (wg - GH) * 8 + wv, (G - GH) * 8); }
        }
        STAMP(2);
        xcd_barrier(xbar, xb_nloc, xb_nx); STAMP(3);
        PH(6) { pg8::Gemm g{P + P_Q, WoaT + (size_t)l * D * D, M, D, D}; pg8::StaticOrder S; S.init(M, D, G, wg); pg8::EpiGate<0> E{P + P_GA, P + P_GB, nullptr}; pg8::gemm_phase(lds, g, S, E); }
        STAMP(6);
        PH(7) { pg8::Gemm g{P + P_GR, WolT + (size_t)l * D * D, M, D, D}; pg8::StaticOrder S; S.init(M, D, G, wg); pg8::EpiGate<1> E{P + P_GA, P + P_GB, nullptr}; pg8::gemm_phase(lds, g, S, E); }
        xcd_barrier(xbar, xb_nloc, xb_nx); STAMP(7);
        PH(8) { pg8::Gemm g{P + P_GA, WoutT + (size_t)l * D * D, M, D, D}; pg8::StaticOrder S; S.init(M, D, G, wg); pg8::EpiRes E{xb, ss}; pg8::gemm_phase(lds, g, S, E); }
        xcd_barrier(xbar, xb_nloc, xb_nx); STAMP(8);
        PH(9) { pg8::Gemm g{xb, WupT + (size_t)l * FF * D, M, FF, D}; pg8::StaticOrder S; S.init(M, FF, G, wg); pg8::EpiUp E{P, ss}; pg8::gemm_phase(lds, g, S, E); }
        xcd_barrier(xbar, xb_nloc, xb_nx); STAMP(9);
        PH(10) { pg8::Gemm g{P, WdnT + (size_t)l * D * FF, M, D, FF}; pg8::StaticOrder S; S.init(M, D, G, wg); pg8::EpiRes E{xb, ss}; pg8::gemm_phase(lds, g, S, E); }
        xcd_barrier(xbar, xb_nloc, xb_nx); STAMP(10);
    }
#ifdef PROBE_A
    if (wg == 0 && tid == 0) { biasT[8192] = exp2f(rintf(log2f(pa) * 3.f) * (1.f / 3.f)); biasT[8193] = exp2f(rintf(log2f(pb) * 3.f) * (1.f / 3.f)) * 0.001f; }
    __threadfence(); xcd_barrier(xbar, xb_nloc, xb_nx);
    const float probeA = biasT[8192], probeB = biasT[8193];
#endif
    PH(11) {
        int tidf = threadIdx.x; asm volatile("" : "+v"(tidf));
        const int lane = tidf & 63, gw = wg * 8 + __builtin_amdgcn_readfirstlane(tidf >> 6);
        const float* gfin = args.in[18];
        f32x4 gv[4];
#pragma unroll
        for (int j = 0; j < 4; ++j) gv[j] = ((const f32x4*)gfin)[lane + 64 * j];
        for (int m0 = 2 * gw; m0 < M; m0 += 2 * NGW) {
            u32x2 t[2][4];
#pragma unroll
            for (int r2 = 0; r2 < 2; ++r2) { const u32x2* xi = (const u32x2*)(xb + (size_t)(m0 + r2) * D) + lane;
#pragma unroll
                for (int j = 0; j < 4; ++j) t[r2][j] = xi[64 * j]; }
#pragma unroll
            for (int r2 = 0; r2 < 2; ++r2) { f32x4 v[4]; float s = 0.f;
#pragma unroll
                for (int j = 0; j < 4; ++j) { v[j] = (f32x4){bflo(t[r2][j].x), bfhi(t[r2][j].x), bflo(t[r2][j].y), bfhi(t[r2][j].y)}; s += (v[j].x * v[j].x + v[j].y * v[j].y) + (v[j].z * v[j].z + v[j].w * v[j].w); }
                s = wave_sum(s);
                const float rs = 1.f / sqrtf(s * (1.f / 1024.f) + 1e-6f);
                f32x4* xr = (f32x4*)(out + (size_t)(m0 + r2) * D) + lane;
#pragma unroll
                for (int j = 0; j < 4; ++j) {
#ifdef PROBE_A
                    f32x4 o = v[j] * rs * gv[j] + probeB; if (m0 + r2 == 0 && lane == 0 && j == 0) o.x += probeA; xr[64 * j] = o;
#else
                    xr[64 * j] = v[j] * rs * gv[j];
#endif
                } }
        }
    }
}

extern "C" void kernel_launch(void* const* d_in, const int* in_sizes, int n_in, void* d_out, int out_size, void* d_ws, size_t ws_size, hipStream_t stream) {
    static int grid = 0;
    if (grid == 0) {
        if (n_in != 19 || out_size != M * D || ws_size < WS_END) { fprintf(stderr, "kernel_launch: unexpected problem: n_in %d out %d ws %zu (need %zu)\n", n_in, out_size, ws_size, (size_t)WS_END); grid = -1; return; }
        int dev = 0, cus = 0, per_cu = 0;
        hipGetDevice(&dev);
        hipDeviceGetAttribute(&cus, hipDeviceAttributeMultiprocessorCount, dev);
        if (hipFuncSetAttribute((const void*)fwd_megakernel, hipFuncAttributeMaxDynamicSharedMemorySize, LDS_BYTES) != hipSuccess) { fprintf(stderr, "kernel_launch: hipFuncSetAttribute failed\n"); grid = -1; return; }
        if (hipOccupancyMaxActiveBlocksPerMultiprocessor(&per_cu, (const void*)fwd_megakernel, 512, LDS_BYTES) != hipSuccess || per_cu < 1) { fprintf(stderr, "kernel_launch: occupancy query gave %d\n", per_cu); per_cu = 1; }
        (void)hipGetLastError();
        grid = cus * per_cu;
    }
    if (grid < 0) return;
    if (hipMemsetAsync((char*)d_ws + WS_CTL, 0, CTL_BYTES, stream) != hipSuccess) { fprintf(stderr, "kernel_launch: memset failed\n"); return; }
    Args a{};
    for (int i = 0; i < 19; ++i) a.in[i] = (const float*)d_in[i];
    a.out = (float*)d_out; a.ws = (unsigned char*)d_ws;
    void* kargs[] = {&a};
    hipError_t e = hipLaunchCooperativeKernel((const void*)fwd_megakernel, dim3(grid), dim3(512), kargs, LDS_BYTES, stream);
    if (e != hipSuccess) fprintf(stderr, "kernel_launch: cooperative launch failed: %s (grid %d)\n", hipGetErrorString(e), grid);
}
```
